# Optimizing an MI355X kernel written in HIP

```python
import jax, jax.numpy as jnp
from jax import lax
import numpy as np

D_MODEL = 1024
BATCH = 2
SEQ = 8192
DEPTH = 2

POOL_WIDTH = 512
POOL_GROUPS = 4
POOL_GROUP_DIM = POOL_WIDTH // POOL_GROUPS
POOL_WINDOWS = (2, 4, 8, 16)
MLA_HEADS = 8
QK_NOPE_DIM = 64
QK_ROPE_DIM = 32
V_HEAD_DIM = 64
Q_LORA_RANK = 256
KV_LORA_RANK = 128
MLA_WIDTH = MLA_HEADS * V_HEAD_DIM
ROPE_THETA = 10000.0
ATTN_BLOCK = 128
GMLP_WIDTH = 512
GMLP_CHUNK = 128
GMLP_GROUPS = 8
GMLP_GROUP_DIM = GMLP_WIDTH // GMLP_GROUPS
N_BRANCHES = 3
EPS = 1e-6
IN_SPLITS = (POOL_WIDTH, POOL_WIDTH, Q_LORA_RANK, KV_LORA_RANK, QK_ROPE_DIM, MLA_WIDTH,
             GMLP_WIDTH, GMLP_WIDTH, GMLP_WIDTH, N_BRANCHES * D_MODEL)
IN_WIDTH = 6560

kernel_name = 'hybrid_gated_pool_mla_gmlp'


def rmsnorm(x, g):
    xf = x.astype(jnp.float32)
    y = xf * lax.rsqrt(jnp.mean(xf * xf, axis=-1, keepdims=True) + EPS) * g.astype(jnp.float32)
    return y.astype(x.dtype)


def layernorm(x, g, b):
    xf = x.astype(jnp.float32)
    mu = jnp.mean(xf, axis=-1, keepdims=True)
    xc = xf - mu
    var = jnp.mean(xc * xc, axis=-1, keepdims=True)
    y = xc * lax.rsqrt(var + EPS) * g.astype(jnp.float32) + b.astype(jnp.float32)
    return y.astype(x.dtype)


def rope_cos_sin(positions, dtype):
    inv_freq = ROPE_THETA ** (-jnp.arange(0, QK_ROPE_DIM, 2, dtype=jnp.float32) / QK_ROPE_DIM)
    ang = positions.astype(jnp.float32)[..., None] * inv_freq
    return jnp.cos(ang).astype(dtype), jnp.sin(ang).astype(dtype)


def apply_rope(x, cos, sin):
    x1, x2 = jnp.split(x, 2, axis=-1)
    return jnp.concatenate([x1 * cos - x2 * sin, x2 * cos + x1 * sin], axis=-1)


def pool_mixer(a, pool_w, pool_scale):
    B, S, _ = a.shape
    a4 = a.reshape(B, S, POOL_GROUPS, POOL_GROUP_DIM)
    cs = jnp.cumsum(a4.astype(jnp.float32), axis=1)
    t = jnp.arange(S)
    pooled = []
    for g, w in enumerate(POOL_WINDOWS):
        csg = cs[:, :, g]
        shifted = jnp.pad(csg, ((0, 0), (w, 0), (0, 0)))[:, :S]
        count = jnp.minimum(t + 1, w).astype(jnp.float32)[None, :, None]
        pooled.append((csg - shifted) / count)
    pooled = jnp.stack(pooled, axis=2)
    mixed = (pooled - a4.astype(jnp.float32)).astype(a.dtype)
    y = jnp.einsum('bsgc,gcd->bsgd', mixed, pool_w)
    return y.reshape(B, S, POOL_WIDTH) * pool_scale


def mla_mixer(cq, ckv, kr, positions, q_norm, w_uq, kv_norm, w_ukv):
    B, S, _ = cq.shape
    q = (rmsnorm(cq, q_norm) @ w_uq).reshape(B, S, MLA_HEADS, QK_NOPE_DIM + QK_ROPE_DIM)
    q_nope, q_rope = q[..., :QK_NOPE_DIM], q[..., QK_NOPE_DIM:]
    kv = (rmsnorm(ckv, kv_norm) @ w_ukv).reshape(B, S, MLA_HEADS, QK_NOPE_DIM + V_HEAD_DIM)
    k_nope, v = kv[..., :QK_NOPE_DIM], kv[..., QK_NOPE_DIM:]
    cos, sin = rope_cos_sin(positions, cq.dtype)
    q_rope = apply_rope(q_rope, cos[:, :, None, :], sin[:, :, None, :])
    k_rope = apply_rope(kr, cos, sin)
    scale = (QK_NOPE_DIM + QK_ROPE_DIM) ** -0.5
    nb = S // ATTN_BLOCK
    qn_b = q_nope.reshape(B, nb, ATTN_BLOCK, MLA_HEADS, QK_NOPE_DIM).transpose(1, 0, 2, 3, 4)
    qr_b = q_rope.reshape(B, nb, ATTN_BLOCK, MLA_HEADS, QK_ROPE_DIM).transpose(1, 0, 2, 3, 4)
    k_idx = jnp.arange(S)

    def attend_block(args):
        qn, qr, i = args
        s = (jnp.einsum('bqhd,bkhd->bhqk', qn, k_nope)
             + jnp.einsum('bqhd,bkd->bhqk', qr, k_rope)).astype(jnp.float32) * scale
        q_idx = i * ATTN_BLOCK + jnp.arange(ATTN_BLOCK)
        mask = k_idx[None, :] <= q_idx[:, None]
        s = jnp.where(mask[None, None], s, -jnp.inf)
        p = jax.nn.softmax(s, axis=-1).astype(v.dtype)
        return jnp.einsum('bhqk,bkhd->bqhd', p, v)

    o = lax.map(attend_block, (qn_b, qr_b, jnp.arange(nb)))
    return o.transpose(1, 0, 2, 3, 4).reshape(B, S, MLA_WIDTH)


def gmlp_mixer(u, v, v_norm_g, v_norm_b, w_s, b_s):
    B, S, _ = v.shape
    v = layernorm(v, v_norm_g, v_norm_b)
    nc = S // GMLP_CHUNK
    vc = v.reshape(B, nc, GMLP_CHUNK, GMLP_GROUPS, GMLP_GROUP_DIM)
    tril = jnp.tril(jnp.ones((GMLP_CHUNK, GMLP_CHUNK), dtype=bool))
    ws = jnp.where(tril[None], w_s, 0)
    sv = jnp.einsum('gts,bnsgc->bntgc', ws, vc) + b_s.T[None, None, :, :, None]
    return u * sv.reshape(B, S, GMLP_WIDTH)


def hybrid_layer(x, positions, norm_pre, norm_post, w_in, b_gate, pool_w, pool_scale,
                 q_norm, w_uq, kv_norm, w_ukv, v_norm_g, v_norm_b, w_s, b_s,
                 w_oa, w_ob, w_oc, w_out):
    B, S, _ = x.shape
    h = rmsnorm(x, norm_pre)
    proj = h @ w_in
    offsets = tuple(int(o) for o in np.cumsum(IN_SPLITS)[:-1])
    (a_in, a_gate, cq, ckv, kr, b_gpath, u, v, c_gate, gates) = jnp.split(proj, offsets, axis=-1)
    y_a = pool_mixer(a_in, pool_w, pool_scale) * jax.nn.silu(a_gate)
    y_b = mla_mixer(cq, ckv, kr, positions, q_norm, w_uq, kv_norm, w_ukv) * jax.nn.silu(b_gpath)
    y_c = gmlp_mixer(u, v, v_norm_g, v_norm_b, w_s, b_s) * jax.nn.silu(c_gate)
    g = jax.nn.sigmoid(gates + b_gate).reshape(B, S, N_BRANCHES, D_MODEL)
    merged = g[:, :, 0] * (y_a @ w_oa) + g[:, :, 1] * (y_b @ w_ob) + g[:, :, 2] * (y_c @ w_oc)
    return x + rmsnorm(merged @ w_out, norm_post)


def setup_inputs(seed: int = 0) -> dict:
    key = jax.random.key(seed)
    ks = jax.random.split(key, 24)
    L = DEPTH

    def nrm(k, shape, scale):
        return jax.random.normal(k, shape, jnp.float32) * scale

    x = nrm(ks[0], (BATCH, SEQ, D_MODEL), 1.0)
    positions = (jax.random.randint(ks[1], (BATCH, 1), 0, 1024, dtype=jnp.int32)
                 + jnp.arange(SEQ, dtype=jnp.int32)[None, :])
    return {
        'x': x,
        'positions': positions,
        'norm_pre': 1.0 + nrm(ks[2], (L, D_MODEL), 0.02),
        'norm_post': 1.0 + nrm(ks[3], (L, D_MODEL), 0.02),
        'w_in': nrm(ks[4], (L, D_MODEL, IN_WIDTH), D_MODEL ** -0.5),
        'b_gate': nrm(ks[5], (L, N_BRANCHES * D_MODEL), 0.01),
        'pool_w': nrm(ks[6], (L, POOL_GROUPS, POOL_GROUP_DIM, POOL_GROUP_DIM), POOL_GROUP_DIM ** -0.5),
        'pool_scale': 1.0 + nrm(ks[7], (L, POOL_WIDTH), 0.02),
        'q_norm': 1.0 + nrm(ks[8], (L, Q_LORA_RANK), 0.02),
        'w_uq': nrm(ks[9], (L, Q_LORA_RANK, MLA_HEADS * (QK_NOPE_DIM + QK_ROPE_DIM)), Q_LORA_RANK ** -0.5),
        'kv_norm': 1.0 + nrm(ks[10], (L, KV_LORA_RANK), 0.02),
        'w_ukv': nrm(ks[11], (L, KV_LORA_RANK, MLA_HEADS * (QK_NOPE_DIM + V_HEAD_DIM)), KV_LORA_RANK ** -0.5),
        'v_norm_g': 1.0 + nrm(ks[12], (L, GMLP_WIDTH), 0.02),
        'v_norm_b': nrm(ks[13], (L, GMLP_WIDTH), 0.02),
        'w_s': nrm(ks[14], (L, GMLP_GROUPS, GMLP_CHUNK, GMLP_CHUNK), GMLP_CHUNK ** -0.5),
        'b_s': 1.0 + nrm(ks[15], (L, GMLP_GROUPS, GMLP_CHUNK), 0.02),
        'w_oa': nrm(ks[16], (L, POOL_WIDTH, D_MODEL), POOL_WIDTH ** -0.5),
        'w_ob': nrm(ks[17], (L, MLA_WIDTH, D_MODEL), MLA_WIDTH ** -0.5),
        'w_oc': nrm(ks[18], (L, GMLP_WIDTH, D_MODEL), GMLP_WIDTH ** -0.5),
        'w_out': nrm(ks[19], (L, D_MODEL, D_MODEL), D_MODEL ** -0.5),
    }


def reference(x, positions, norm_pre, norm_post, w_in, b_gate, pool_w, pool_scale,
              q_norm, w_uq, kv_norm, w_ukv, v_norm_g, v_norm_b, w_s, b_s,
              w_oa, w_ob, w_oc, w_out):
    for l in range(DEPTH):
        x = hybrid_layer(x, positions, norm_pre[l], norm_post[l], w_in[l], b_gate[l],
                         pool_w[l], pool_scale[l], q_norm[l], w_uq[l], kv_norm[l], w_ukv[l],
                         v_norm_g[l], v_norm_b[l], w_s[l], b_s[l],
                         w_oa[l], w_ob[l], w_oc[l], w_out[l])
    return x
```

```cpp
#include <hip/hip_runtime.h>
#include <hip/hip_bf16.h>
#include <cstdio>
#include <cstdint>
#include <cmath>

#ifndef MK_SINGLE
#define MK_SINGLE 0
#endif

#define LAS __attribute__((address_space(3)))
#define GAS __attribute__((address_space(1)))
typedef unsigned short bf16_t;
typedef short bf16x8 __attribute__((ext_vector_type(8)));
typedef short s16x4 __attribute__((ext_vector_type(4)));
typedef float f32x4 __attribute__((ext_vector_type(4)));
typedef float f32x2 __attribute__((ext_vector_type(2)));
typedef float f32x16 __attribute__((ext_vector_type(16)));
typedef unsigned u32x4 __attribute__((ext_vector_type(4)));
typedef unsigned u32x2 __attribute__((ext_vector_type(2)));
typedef __bf16 bf16x2_t __attribute__((ext_vector_type(2)));

constexpr int BATCH = 2, SEQ = 8192, DM = 1024, M = BATCH * SEQ, DEPTH = 2;
constexpr int NPROJ = 3584, NGATE = 3072, NIN = NPROJ + NGATE;
constexpr int PLD = 2048;
constexpr int YLD = 1536;
constexpr int QLD = 768, VLD = 512, GLD = 3072;
constexpr float EPS = 1e-6f;
constexpr float QSCALE = 0.10206207261596575f * 1.4426950408889634f;

constexpr size_t MiB = 1u << 20;
constexpr size_t WS_CTL = 0, CTL_ZERO_BYTES = 1 * MiB;
constexpr size_t WS_CS = 1 * MiB;
constexpr size_t WS_W = 3 * MiB, W_LAYER = 20 * MiB;
constexpr size_t W_IN = 0, W_UQ = 13 * MiB, W_UKV = 13 * MiB + 512 * 1024, W_POOL = 13 * MiB + 768 * 1024, W_S = 14 * MiB,
                 W_OA = 14 * MiB + 256 * 1024, W_OUT = 17 * MiB + 256 * 1024;
constexpr size_t WS_H = 43 * MiB;
constexpr size_t WS_PROJ = 75 * MiB;
constexpr size_t WS_Q = 139 * MiB, WS_K = 163 * MiB, WS_V = 187 * MiB;
constexpr size_t WS_Y = 203 * MiB;
constexpr size_t WS_END = 251 * MiB;
constexpr int CW_BAR = 4096;

__device__ __forceinline__ unsigned cvtpk(float lo, float hi) { f32x2 v = {lo, hi}; bf16x2_t b = __builtin_convertvector(v, bf16x2_t); return __builtin_bit_cast(unsigned, b); }
__device__ __forceinline__ float bf_lo(unsigned w) { return __uint_as_float(w << 16); }
__device__ __forceinline__ float bf_hi(unsigned w) { return __uint_as_float(w & 0xffff0000u); }
__device__ __forceinline__ float bf2f(bf16_t h) { return __uint_as_float(((unsigned)h) << 16); }
__device__ __forceinline__ bf16_t f2bf(float f) { return (bf16_t)(cvtpk(f, 0.f) & 0xffffu); }
__device__ __forceinline__ float sigmoid_f(float v) { return __builtin_amdgcn_rcpf(1.f + __builtin_amdgcn_exp2f(-1.4426950408889634f * v)); }
__device__ __forceinline__ float silu_f(float v) { return v * sigmoid_f(v); }
__device__ __forceinline__ float wave_sum(float v) {
#pragma unroll
    for (int o = 1; o < 64; o <<= 1) v += __shfl_xor(v, o);
    return v;
}
#define LDS_WAIT() asm volatile("s_waitcnt lgkmcnt(0)" ::: "memory")
#define VM_WAIT() asm volatile("s_waitcnt vmcnt(0)" ::: "memory")

namespace pg8 {
constexpr int BM = 256, BK = 64, HALF = 128, HTB = HALF * BK * 2, STAGE_BYTES = 8 * HTB, NXCD = 8, WGM = 8;
__host__ __device__ __forceinline__ int lds_byte(int r, int c) { const int st = (r >> 4) * 2 + (c >> 5), rr = r & 15, cc = c & 31, ob = rr * 64 + cc * 2; return st * 1024 + (ob ^ (((ob >> 9) & 1) << 5)); }
__host__ __device__ __forceinline__ void stage_rc(int b, int& R, int& C) { const int st = b / 1024, sb = b % 1024, swz = sb ^ (((sb >> 9) & 1) << 5); R = (st >> 1) * 16 + swz / 64; C = (st & 1) * 32 + (swz % 64) / 2; }
__host__ __device__ __forceinline__ int perm32(int rho) { const int n = rho >> 4, i = rho & 15; return 8 * (i >> 2) + 4 * n + (i & 3); }

struct Unit { int pm, pn, br; };
struct TileOrder {
    int nM, nN, nwg, G, c;
    __device__ __forceinline__ void init(int Mrows, int N, int G_, int c_) { nM = Mrows / BM; nN = N / BM; nwg = nM * nN; G = G_; c = c_; }
    __device__ __forceinline__ bool tile(int i, int& pm, int& pn) const {
        const long L = (long)i * G + c; if (L >= nwg) return false;
        int wgid = (int)L; { const int q = nwg / NXCD, r = nwg % NXCD, xcd = wgid % NXCD, off = wgid / NXCD; wgid = (xcd < r ? xcd * (q + 1) : r * (q + 1) + (xcd - r) * q) + off; }
        const int nig = WGM * nN, gid = wgid / nig, fm = gid * WGM, gsz = (nM - fm) < WGM ? (nM - fm) : WGM;
        pm = fm + ((wgid % nig) % gsz); pn = (wgid % nig) / gsz; return true;
    }
};
struct Prob {
    const bf16_t* A; const bf16_t* Bt; int lda, ldb, K; TileOrder T;
    int a_col_per_pn, a_col0;
    int a_col_per_br; size_t b_per_br; int nbr;
    __device__ __forceinline__ bool next(int i, Unit& u) const { const int ti = i / nbr; u.br = i - ti * nbr; return T.tile(ti, u.pm, u.pn); }
    __device__ __forceinline__ const char* aptr(const Unit& u) const { return (const char*)(A + (size_t)u.pm * BM * lda + a_col0 + a_col_per_pn * u.pn + a_col_per_br * u.br); }
    __device__ __forceinline__ const char* bptr(const Unit& u) const { return (const char*)(Bt + (size_t)u.pn * BM * ldb + b_per_br * u.br); }
};

template <class Epi, bool ALIGN_EPI, bool SP2>
__device__ __forceinline__ void gemm_phase(LAS unsigned char* lds, const Prob& P, const Epi& E) {
    int tid = threadIdx.x; asm volatile("" : "+v"(tid));
    const int wid = __builtin_amdgcn_readfirstlane(tid >> 6), lane = tid & 63, wr = wid >> 2, wc = wid & 3, fr = lane & 15, fq = lane >> 4;
    int nt = P.K / BK; asm volatile("" : "+s"(nt));
    unsigned voffA[2], voffB[2];
#pragma unroll
    for (int i = 0; i < 2; ++i) { int R, C; stage_rc(tid * 16 + i * 8192, R, C); const int Rb = Epi::PERM ? ((R & ~31) + perm32(R & 31)) : R;
        voffA[i] = (unsigned)(R * P.lda + C) * 2u; voffB[i] = (unsigned)(Rb * P.ldb + C) * 2u; }
    const size_t kstep = (size_t)(BK * 2);
    const size_t hstepA = (size_t)HALF * P.lda * 2, hstepB = (size_t)HALF * P.ldb * 2;
    const unsigned ldsw = (unsigned)wid * 1024u;
    const int aoff = lds_byte(wr * 64 + fr, fq * 8), boff = lds_byte(wc * 32 + fr, fq * 8);
#define PG8_SA(b, h) (((b) * 2 + (h)) * HTB)
#define PG8_SB(b, h) ((4 + (b) * 2 + (h)) * HTB)
#define PG8_STAGE(bufoff, gbase, voff) do { _Pragma("unroll") for (int _i = 0; _i < 2; ++_i) \
        __builtin_amdgcn_global_load_lds((const unsigned*)((const char*)(gbase) + (voff)[_i]), (LAS unsigned*)(lds + (bufoff) + ldsw + _i * 8192), 16, 0, 0); } while (0)
#define PG8_LDA(dst, b, h) do { _Pragma("unroll") for (int m = 0; m < 4; ++m) _Pragma("unroll") for (int k = 0; k < 2; ++k) dst[m][k] = *(const LAS bf16x8*)(lds + PG8_SA(b, h) + aoff + m * 2048 + k * 1024); } while (0)
#define PG8_LDB(dst, b, h) do { _Pragma("unroll") for (int n = 0; n < 2; ++n) _Pragma("unroll") for (int k = 0; k < 2; ++k) dst[n][k] = *(const LAS bf16x8*)(lds + PG8_SB(b, h) + boff + n * 2048 + k * 1024); } while (0)
#define PG8_MMA(ai, bj, At, Bt) do { __builtin_amdgcn_s_setprio(1); _Pragma("unroll") for (int m = 0; m < 4; ++m) _Pragma("unroll") for (int n = 0; n < 2; ++n) _Pragma("unroll") for (int k = 0; k < 2; ++k) \
        acc[ai][bj][m][n] = __builtin_amdgcn_mfma_f32_16x16x32_bf16(Bt[n][k], At[m][k], acc[ai][bj][m][n], 0, 0, 0); __builtin_amdgcn_s_setprio(0); } while (0)
#define PG8_WAIT_V(n) asm volatile("s_waitcnt vmcnt(" #n ")" ::: "memory")
#define PG8_WAIT_L(n) asm volatile("s_waitcnt lgkmcnt(" #n ")" ::: "memory")
#define PG8_BAR __builtin_amdgcn_s_barrier()
#define PG8_SCHED __builtin_amdgcn_sched_barrier(0)
    Unit cur, nxt; int ui = 0;
    if (!P.next(0, cur)) return;
    f32x4 acc[2][2][4][2];
#pragma unroll
    for (int a = 0; a < 2; ++a)
#pragma unroll
        for (int b = 0; b < 2; ++b)
#pragma unroll
            for (int m = 0; m < 4; ++m)
#pragma unroll
                for (int n = 0; n < 2; ++n) acc[a][b][m][n] = (f32x4){0.f, 0.f, 0.f, 0.f};
    bf16x8 At[4][2], B0[2][2], B1[2][2];
    const char* cA = P.aptr(cur); const char* cB = P.bptr(cur);
    if constexpr (SP2) {
        PG8_STAGE(PG8_SB(0, 0), cB, voffB); PG8_STAGE(PG8_SB(0, 1), cB + hstepB, voffB); PG8_STAGE(PG8_SA(0, 0), cA, voffA); PG8_STAGE(PG8_SA(0, 1), cA + hstepA, voffA);
        if (wr == 1) PG8_BAR;
        PG8_WAIT_V(2); PG8_BAR;
        PG8_STAGE(PG8_SB(1, 0), cB + kstep, voffB); PG8_STAGE(PG8_SA(1, 0), cA + kstep, voffA); PG8_STAGE(PG8_SB(1, 1), cB + hstepB + kstep, voffB);
        PG8_WAIT_V(6); PG8_BAR;
    } else {
        PG8_STAGE(PG8_SB(0, 0), cB, voffB); PG8_STAGE(PG8_SA(0, 0), cA, voffA); PG8_STAGE(PG8_SB(0, 1), cB + hstepB, voffB); PG8_STAGE(PG8_SA(0, 1), cA + hstepA, voffA);
        if (wr == 1) PG8_BAR;
        PG8_WAIT_V(4); PG8_BAR;
        PG8_STAGE(PG8_SB(1, 0), cB + kstep, voffB); PG8_STAGE(PG8_SA(1, 0), cA + kstep, voffA); PG8_STAGE(PG8_SB(1, 1), cB + hstepB + kstep, voffB);
        PG8_WAIT_V(6); PG8_BAR;
    }
    for (;;) {
        const bool has_next = P.next(ui + 1, nxt);
        const char* nA = has_next ? P.aptr(nxt) : cA; const char* nB = has_next ? P.bptr(nxt) : cB;
        for (int t = 0; t < nt; t += 2) {
            const bool last = (t == nt - 2);
            const char* a1 = cA + (size_t)(t + 1) * kstep;
            const char* a2 = last ? nA : cA + (size_t)(t + 2) * kstep; const char* b2 = last ? nB : cB + (size_t)(t + 2) * kstep;
            const char* a3 = a2 + kstep; const char* b3 = b2 + kstep;
            if constexpr (SP2) {
            PG8_LDB(B0, 0, 0); PG8_LDB(B1, 0, 1); PG8_SCHED; PG8_LDA(At, 0, 0); PG8_STAGE(PG8_SA(1, 1), a1 + hstepA, voffA);
            PG8_WAIT_V(8); PG8_WAIT_L(0); PG8_BAR; PG8_MMA(0, 0, At, B0); PG8_MMA(0, 1, At, B1); PG8_BAR; PG8_SCHED;
            PG8_LDA(At, 0, 1); PG8_STAGE(PG8_SB(0, 0), b2, voffB); PG8_STAGE(PG8_SB(0, 1), b2 + hstepB, voffB); PG8_STAGE(PG8_SA(0, 0), a2, voffA);
            PG8_WAIT_V(8); PG8_WAIT_L(0); PG8_BAR; PG8_MMA(1, 0, At, B0); PG8_MMA(1, 1, At, B1); PG8_BAR; PG8_SCHED;
            PG8_LDB(B0, 1, 0); PG8_LDB(B1, 1, 1); PG8_SCHED; PG8_LDA(At, 1, 0); PG8_STAGE(PG8_SA(0, 1), a2 + hstepA, voffA);
            PG8_WAIT_V(8); PG8_WAIT_L(0); PG8_BAR; PG8_MMA(0, 0, At, B0); PG8_MMA(0, 1, At, B1); PG8_BAR; PG8_SCHED;
            PG8_LDA(At, 1, 1); PG8_STAGE(PG8_SB(1, 0), b3, voffB); PG8_STAGE(PG8_SB(1, 1), b3 + hstepB, voffB); PG8_STAGE(PG8_SA(1, 0), a3, voffA);
            PG8_WAIT_V(8); PG8_WAIT_L(0); PG8_BAR; PG8_MMA(1, 0, At, B0); PG8_MMA(1, 1, At, B1); PG8_BAR; PG8_SCHED;
            } else {
            PG8_LDB(B0, 0, 0); PG8_SCHED; PG8_LDA(At, 0, 0); PG8_STAGE(PG8_SA(1, 1), a1 + hstepA, voffA);
            PG8_WAIT_L(8); PG8_BAR; PG8_WAIT_L(0); PG8_MMA(0, 0, At, B0); PG8_BAR; PG8_SCHED;
            PG8_LDB(B1, 0, 1); PG8_STAGE(PG8_SB(0, 0), b2, voffB);
            PG8_BAR; PG8_WAIT_L(0); PG8_MMA(0, 1, At, B1); PG8_BAR;
            PG8_LDA(At, 0, 1); PG8_STAGE(PG8_SA(0, 0), a2, voffA);
            PG8_BAR; PG8_WAIT_L(0); PG8_MMA(1, 0, At, B0); PG8_BAR; PG8_SCHED;
            PG8_STAGE(PG8_SB(0, 1), b2 + hstepB, voffB);
            PG8_WAIT_V(6); PG8_BAR; PG8_MMA(1, 1, At, B1); PG8_BAR;
            PG8_LDB(B0, 1, 0); PG8_SCHED; PG8_LDA(At, 1, 0); PG8_STAGE(PG8_SA(0, 1), a2 + hstepA, voffA);
            PG8_WAIT_L(8); PG8_BAR; PG8_WAIT_L(0); PG8_MMA(0, 0, At, B0); PG8_BAR; PG8_SCHED;
            PG8_LDB(B1, 1, 1); PG8_STAGE(PG8_SB(1, 0), b3, voffB);
            PG8_BAR; PG8_WAIT_L(0); PG8_MMA(0, 1, At, B1); PG8_BAR;
            PG8_LDA(At, 1, 1); PG8_STAGE(PG8_SA(1, 0), a3, voffA);
            PG8_BAR; PG8_WAIT_L(0); PG8_MMA(1, 0, At, B0); PG8_BAR; PG8_SCHED;
            PG8_STAGE(PG8_SB(1, 1), b3 + hstepB, voffB);
            PG8_WAIT_V(6); PG8_BAR; PG8_MMA(1, 1, At, B1); PG8_BAR;
            }
        }
        if constexpr (ALIGN_EPI) { if (wr == 0) PG8_BAR; }
        const bool keep = E(acc, cur, wr, wc, fr, fq);
        if (!has_next) break;
        if (!keep) {
#pragma unroll
        for (int a = 0; a < 2; ++a)
#pragma unroll
            for (int b = 0; b < 2; ++b)
#pragma unroll
                for (int m = 0; m < 4; ++m)
#pragma unroll
                    for (int n = 0; n < 2; ++n) acc[a][b][m][n] = (f32x4){0.f, 0.f, 0.f, 0.f};
        }
        cur = nxt; cA = nA; cB = nB; ++ui;
        if constexpr (ALIGN_EPI) { if (wr == 1) PG8_BAR; }
    }
    PG8_WAIT_V(0);
    if constexpr (!ALIGN_EPI) { if (wr == 0) PG8_BAR; }
    PG8_BAR;
#undef PG8_SA
#undef PG8_SB
#undef PG8_STAGE
#undef PG8_LDA
#undef PG8_LDB
#undef PG8_MMA
#undef PG8_WAIT_V
#undef PG8_WAIT_L
#undef PG8_BAR
#undef PG8_SCHED
}

typedef f32x4 Acc[2][2][4][2];
__device__ __forceinline__ void store8(bf16_t* p, f32x4 v0, f32x4 v1) { u32x4 w; w.x = cvtpk(v0[0], v0[1]); w.y = cvtpk(v0[2], v0[3]); w.z = cvtpk(v1[0], v1[1]); w.w = cvtpk(v1[2], v1[3]); *(u32x4*)p = w; }

struct EpiProj {
    static constexpr bool PERM = true;
    bf16_t* proj; bf16_t* y;
    __device__ __forceinline__ bool operator()(Acc& acc, const Unit& u, int wr, int wc, int fr, int fq) const {
        const bool act = u.pn >= 8;
        bf16_t* base = act ? y + (u.pn - 8) * 256 : proj + u.pn * 256; const int ld = act ? YLD : PLD;
        const int row0 = u.pm * BM + wr * 64 + fr, col0 = wc * 32 + 8 * fq;
#pragma unroll
        for (int ai = 0; ai < 2; ++ai)
#pragma unroll
            for (int m = 0; m < 4; ++m) { bf16_t* rowp = base + (size_t)(row0 + ai * HALF + m * 16) * ld + col0;
#pragma unroll
                for (int bj = 0; bj < 2; ++bj) { f32x4 v0 = acc[ai][bj][m][0], v1 = acc[ai][bj][m][1];
                    if (act) {
#pragma unroll
                        for (int e = 0; e < 4; ++e) { v0[e] = silu_f(v0[e]); v1[e] = silu_f(v1[e]); } }
                    store8(rowp + bj * HALF, v0, v1); } }
        return false;
    }
};
struct EpiGate {
    static constexpr bool PERM = true;
    bf16_t* g; const float* bias;
    __device__ __forceinline__ bool operator()(Acc& acc, const Unit& u, int wr, int wc, int fr, int fq) const {
        const int row0 = u.pm * BM + wr * 64 + fr, col0 = u.pn * BM + wc * 32 + 8 * fq;
        f32x4 bv[2][2];
#pragma unroll
        for (int bj = 0; bj < 2; ++bj)
#pragma unroll
            for (int n = 0; n < 2; ++n) bv[bj][n] = *(const f32x4*)(bias + col0 + bj * HALF + 4 * n);
#pragma unroll
        for (int ai = 0; ai < 2; ++ai)
#pragma unroll
            for (int m = 0; m < 4; ++m) { bf16_t* rowp = g + (size_t)(row0 + ai * HALF + m * 16) * GLD + col0;
#pragma unroll
                for (int bj = 0; bj < 2; ++bj) { f32x4 v0 = acc[ai][bj][m][0] + bv[bj][0], v1 = acc[ai][bj][m][1] + bv[bj][1];
#pragma unroll
                    for (int e = 0; e < 4; ++e) { v0[e] = sigmoid_f(v0[e]); v1[e] = sigmoid_f(v1[e]); }
                    store8(rowp + bj * HALF, v0, v1); } }
        return false;
    }
};
struct EpiQ {
    static constexpr bool PERM = true;
    bf16_t* q; const float* cs;
    __device__ __forceinline__ bool operator()(Acc& acc, const Unit& u, int wr, int wc, int fr, int fq) const {
        const int row0 = u.pm * BM + wr * 64 + fr, col0 = u.pn * BM + wc * 32 + 8 * fq;
#pragma unroll
        for (int ai = 0; ai < 2; ++ai)
#pragma unroll
            for (int m = 0; m < 4; ++m) { const int row = row0 + ai * HALF + m * 16; bf16_t* rowp = q + (size_t)row * QLD + col0;
#pragma unroll
                for (int bj = 0; bj < 2; ++bj) { f32x4 v0 = acc[ai][bj][m][0], v1 = acc[ai][bj][m][1];
                    const int d = (col0 + bj * HALF) % 96;
                    if (d >= 64) { const float* c = cs + (size_t)row * 32 + (d - 64); const f32x4 c0 = *(const f32x4*)c, c1 = *(const f32x4*)(c + 4);
                        f32x4 o0, o1;
                        o0[0] = v0[0] * c0[0] - v0[1] * c0[1]; o0[1] = v0[1] * c0[0] + v0[0] * c0[1];
                        o0[2] = v0[2] * c0[2] - v0[3] * c0[3]; o0[3] = v0[3] * c0[2] + v0[2] * c0[3];
                        o1[0] = v1[0] * c1[0] - v1[1] * c1[1]; o1[1] = v1[1] * c1[0] + v1[0] * c1[1];
                        o1[2] = v1[2] * c1[2] - v1[3] * c1[3]; o1[3] = v1[3] * c1[2] + v1[2] * c1[3];
                        v0 = o0; v1 = o1; }
                    store8(rowp + bj * HALF, v0 * QSCALE, v1 * QSCALE); } }
        return false;
    }
};
struct EpiKV {
    static constexpr bool PERM = true;
    bf16_t* k; bf16_t* v;
    __device__ __forceinline__ bool operator()(Acc& acc, const Unit& u, int wr, int wc, int fr, int fq) const {
        const int row0 = u.pm * BM + wr * 64 + fr, col0 = u.pn * BM + wc * 32 + 8 * fq;
#pragma unroll
        for (int ai = 0; ai < 2; ++ai)
#pragma unroll
            for (int m = 0; m < 4; ++m) { const int row = row0 + ai * HALF + m * 16;
#pragma unroll
                for (int bj = 0; bj < 2; ++bj) { const int c = col0 + bj * HALF, head = c >> 7, d = c & 127;
                    bf16_t* p = d < 64 ? k + (size_t)row * QLD + head * 96 + d : v + (size_t)row * VLD + head * 64 + (d - 64);
                    store8(p, acc[ai][bj][m][0], acc[ai][bj][m][1]); } }
        return false;
    }
};
struct EpiPlain {
    static constexpr bool PERM = true;
    bf16_t* o; int ld;
    __device__ __forceinline__ bool operator()(Acc& acc, const Unit& u, int wr, int wc, int fr, int fq) const {
        const int row0 = u.pm * BM + wr * 64 + fr, col0 = u.pn * BM + wc * 32 + 8 * fq;
#pragma unroll
        for (int ai = 0; ai < 2; ++ai)
#pragma unroll
            for (int m = 0; m < 4; ++m) { bf16_t* rowp = o + (size_t)(row0 + ai * HALF + m * 16) * ld + col0;
#pragma unroll
                for (int bj = 0; bj < 2; ++bj) store8(rowp + bj * HALF, acc[ai][bj][m][0], acc[ai][bj][m][1]); }
        return false;
    }
};
struct EpiMerge {
    static constexpr bool PERM = true;
    const bf16_t* g; bf16_t* o;
    __device__ __forceinline__ bool operator()(Acc& acc, const Unit& u, int wr, int wc, int fr, int fq) const {
        const int row0 = u.pm * BM + wr * 64 + fr, col0 = u.pn * BM + wc * 32 + 8 * fq;
        const bool fin = u.br == 2;
#pragma unroll
        for (int ai = 0; ai < 2; ++ai)
#pragma unroll
            for (int m = 0; m < 4; ++m) { const size_t row = (size_t)(row0 + ai * HALF + m * 16);
#pragma unroll
                for (int bj = 0; bj < 2; ++bj) {
                    const u32x4 ga = *(const u32x4*)(g + row * GLD + u.br * 1024 + col0 + bj * HALF);
                    float f[8] = {bf_lo(ga.x), bf_hi(ga.x), bf_lo(ga.y), bf_hi(ga.y), bf_lo(ga.z), bf_hi(ga.z), bf_lo(ga.w), bf_hi(ga.w)};
                    if (!fin) { const u32x4 gb = *(const u32x4*)(g + row * GLD + (u.br + 1) * 1024 + col0 + bj * HALF);
                        const float h[8] = {bf_lo(gb.x), bf_hi(gb.x), bf_lo(gb.y), bf_hi(gb.y), bf_lo(gb.z), bf_hi(gb.z), bf_lo(gb.w), bf_hi(gb.w)};
#pragma unroll
                        for (int e = 0; e < 8; ++e) f[e] *= __builtin_amdgcn_rcpf(h[e]); }
                    f32x4 v0 = acc[ai][bj][m][0], v1 = acc[ai][bj][m][1];
#pragma unroll
                    for (int e = 0; e < 4; ++e) { v0[e] *= f[e]; v1[e] *= f[4 + e]; }
                    if (fin) store8(o + row * DM + col0 + bj * HALF, v0, v1);
                    else { acc[ai][bj][m][0] = v0; acc[ai][bj][m][1] = v1; } } }
        return !fin;
    }
};
struct EpiZ {
    static constexpr bool PERM = false;
    float* z;
    __device__ __forceinline__ bool operator()(Acc& acc, const Unit& u, int wr, int wc, int fr, int fq) const {
        const int row0 = u.pm * BM + wr * 64 + fr, col0 = u.pn * BM + wc * 32 + 4 * fq;
#pragma unroll
        for (int ai = 0; ai < 2; ++ai)
#pragma unroll
            for (int m = 0; m < 4; ++m) { float* rowp = z + (size_t)(row0 + ai * HALF + m * 16) * DM + col0;
#pragma unroll
                for (int bj = 0; bj < 2; ++bj)
#pragma unroll
                    for (int n = 0; n < 2; ++n) *(f32x4*)(rowp + bj * HALF + n * 16) = acc[ai][bj][m][n]; }
        return false;
    }
};
}

namespace att {
constexpr int NW = 8, QBLK = 32, QB = 256, KVBLK = 64;
constexpr int KSLOT = 12288, VSLOT = 8192;
constexpr int LDS_K = 0, LDS_V = 2 * KSLOT, LDS_WS = LDS_V + 2 * VSLOT, LDS_OST = LDS_WS + NW * 256, LDS_BYTES = LDS_OST + NW * 4096;
__device__ __forceinline__ int crow(int r, int hi) { return (r & 3) + 8 * (r >> 2) + 4 * hi; }
__device__ __forceinline__ void glds16(const void* gsrc, unsigned lds_dst) { unsigned keep;
    asm volatile("s_mov_b32 %0, m0\n\ts_mov_b32 m0, %2\n\ts_nop 0\n\tglobal_load_lds_dwordx4 %1, off\n\ts_mov_b32 m0, %0" : "=&s"(keep) : "v"(gsrc), "s"(lds_dst) : "memory"); }
#define ATT_WAIT_BAR(N) asm volatile("s_waitcnt vmcnt(" #N ") lgkmcnt(0)\n\ts_barrier" ::: "memory")
typedef LAS const char* lds_cptr;
typedef short v4i16_t __attribute__((ext_vector_type(4)));
__device__ __forceinline__ s16x4 vtr(lds_cptr p) { return __builtin_bit_cast(s16x4, __builtin_amdgcn_ds_read_tr16_b64_v4i16((LAS v4i16_t*)p)); }
__device__ __forceinline__ float rowmax32(const f32x16& p0, const f32x16& p1) {
    float a = fmaxf(p0[0], p1[0]);
#pragma unroll
    for (int r = 1; r < 16; ++r) a = fmaxf(a, fmaxf(p0[r], p1[r]));
    auto rr = __builtin_amdgcn_permlane32_swap(__float_as_uint(a), __float_as_uint(a), false, false);
    return fmaxf(__uint_as_float(rr[0]), __uint_as_float(rr[1]));
}

__device__ __forceinline__ void attn_unit(int b, int h, int qb, const bf16_t* Q, const bf16_t* K, const bf16_t* V, bf16_t* Y, LAS char* shm, unsigned lds0) {
    int tid = threadIdx.x; asm volatile("" : "+v"(tid));
    const int lane = tid & 63, r32 = lane & 31, hi = lane >> 5; const int wid = __builtin_amdgcn_readfirstlane(tid >> 6);
    const long rowbase = (long)b * SEQ; const int q0 = qb * QB;
    const bf16_t* Qw = Q + (rowbase + q0 + wid * QBLK) * QLD + h * 96;
    const bf16_t* Kh = K + rowbase * QLD + h * 96; const bf16_t* Vh = V + rowbase * VLD + h * 64;
    LAS float* wsf = (LAS float*)(shm + LDS_WS) + wid * 64;
    const int c2 = 8 + (wid & 3);
    const bf16_t* ksrc0 = Kh + (long)lane * QLD + wid * 8; const bf16_t* ksrc1 = Kh + (long)lane * QLD + c2 * 8;
    const bf16_t* vsrc = Vh + (long)(16 * (wid & 3) + (lane >> 2)) * VLD + (wid >> 2) * 32 + (lane & 3) * 8;
    const unsigned kdst0 = lds0 + LDS_K + wid * 1024, kdst1 = lds0 + LDS_K + c2 * 1024, vdst = lds0 + LDS_V + wid * 1024;
#define ATT_DMA(t, s) do { glds16(ksrc0 + (long)(t) * KVBLK * QLD, (unsigned)__builtin_amdgcn_readfirstlane(kdst0 + (s) * KSLOT)); \
                           glds16(ksrc1 + (long)(t) * KVBLK * QLD, (unsigned)__builtin_amdgcn_readfirstlane(kdst1 + (s) * KSLOT)); \
                           glds16(vsrc + (long)(t) * KVBLK * VLD, (unsigned)__builtin_amdgcn_readfirstlane(vdst + (s) * VSLOT)); } while (0)
    const int NT = (q0 + QB) / KVBLK;
    ATT_DMA(0, 0);
    bf16x8 qr[6];
#pragma unroll
    for (int d0 = 0; d0 < 6; ++d0) qr[d0] = *(const bf16x8*)(Qw + (long)r32 * QLD + d0 * 16 + hi * 8);
    float mrow = -1e30f, l_reg = 0.f; f32x16 o[2]; o[0] = f32x16{}; o[1] = f32x16{};
    const int qrel = wid * QBLK + r32;
    const lds_cptr kp0 = (lds_cptr)shm + LDS_K + hi * 1024 + r32 * 16;
    const lds_cptr vp0 = (lds_cptr)shm + LDS_V + ((lane >> 4) & 1) * 32 + (lane & 3) * 8 + (4 * hi + ((lane & 15) >> 2)) * 64;
    for (int t = 0; t < NT; ++t) {
        ATT_WAIT_BAR(0);
        if (t + 1 < NT) ATT_DMA(t + 1, (t + 1) & 1);
        const lds_cptr kp = kp0 + (t & 1) * KSLOT; const lds_cptr vp = vp0 + (t & 1) * VSLOT;
        f32x16 p0 = f32x16{}, p1 = f32x16{};
#pragma unroll
        for (int d0 = 0; d0 < 6; ++d0) {
            const bf16x8 k0 = *(const LAS bf16x8*)(kp + d0 * 2048), k1 = *(const LAS bf16x8*)(kp + d0 * 2048 + 512);
            p0 = __builtin_amdgcn_mfma_f32_32x32x16_bf16(k0, qr[d0], p0, 0, 0, 0);
            p1 = __builtin_amdgcn_mfma_f32_32x32x16_bf16(k1, qr[d0], p1, 0, 0, 0);
        }
        const int jb = t - (NT - 4);
        if (jb >= 0) { const int kb = 64 * jb + 4 * hi;
#pragma unroll
            for (int r = 0; r < 16; ++r) { const int kv = kb + (r & 3) + 8 * (r >> 2); if (kv > qrel) p0[r] = -INFINITY; if (kv + 32 > qrel) p1[r] = -INFINITY; } }
        const float rm = rowmax32(p0, p1);
        const float mn = fmaxf(mrow, rm), alpha = __builtin_amdgcn_exp2f(mrow - mn);
        mrow = mn;
        float ls = 0.f;
#pragma unroll
        for (int r = 0; r < 16; ++r) { p0[r] = __builtin_amdgcn_exp2f(p0[r] - mn); p1[r] = __builtin_amdgcn_exp2f(p1[r] - mn); ls += p0[r] + p1[r]; }
        l_reg = l_reg * alpha + ls;
        if (__any(alpha != 1.f)) {
            if (hi == 0) wsf[r32] = alpha;
            LDS_WAIT();
#pragma unroll
            for (int r = 0; r < 16; ++r) { const float f = wsf[crow(r, hi)]; o[0][r] *= f; o[1][r] *= f; }
            LDS_WAIT();
        }
        u32x4 pw[4];
        pw[0] = (u32x4){cvtpk(p0[0], p0[1]), cvtpk(p0[2], p0[3]), cvtpk(p0[4], p0[5]), cvtpk(p0[6], p0[7])};
        pw[1] = (u32x4){cvtpk(p0[8], p0[9]), cvtpk(p0[10], p0[11]), cvtpk(p0[12], p0[13]), cvtpk(p0[14], p0[15])};
        pw[2] = (u32x4){cvtpk(p1[0], p1[1]), cvtpk(p1[2], p1[3]), cvtpk(p1[4], p1[5]), cvtpk(p1[6], p1[7])};
        pw[3] = (u32x4){cvtpk(p1[8], p1[9]), cvtpk(p1[10], p1[11]), cvtpk(p1[12], p1[13]), cvtpk(p1[14], p1[15])};
#pragma unroll
        for (int d0 = 0; d0 < 2; ++d0)
#pragma unroll
            for (int ks = 0; ks < 4; ++ks) {
                const s16x4 lo = vtr(vp + d0 * 4096 + ks * 1024), hh = vtr(vp + d0 * 4096 + ks * 1024 + 512);
                const bf16x8 vf = (bf16x8){lo[0], lo[1], lo[2], lo[3], hh[0], hh[1], hh[2], hh[3]};
                o[d0] = __builtin_amdgcn_mfma_f32_32x32x16_bf16(__builtin_bit_cast(bf16x8, pw[ks]), vf, o[d0], 0, 0, 0);
            }
    }
    { auto rr = __builtin_amdgcn_permlane32_swap(__float_as_uint(l_reg), __float_as_uint(l_reg), false, false); l_reg = __uint_as_float(rr[0]) + __uint_as_float(rr[1]); }
    if (hi == 0) wsf[32 + r32] = l_reg; LDS_WAIT();
    float rli[16];
#pragma unroll
    for (int r = 0; r < 16; ++r) rli[r] = __builtin_amdgcn_rcpf(wsf[32 + crow(r, hi)]);
    bf16_t* Yw = Y + (rowbase + q0 + wid * QBLK) * YLD + 512 + h * 64;
    { LAS bf16_t* stg = (LAS bf16_t*)(shm + LDS_OST) + wid * 2048;
#pragma unroll
      for (int r = 0; r < 16; ++r) { const int orow = crow(r, hi);
#pragma unroll
          for (int d0 = 0; d0 < 2; ++d0) stg[orow * 64 + d0 * 32 + r32] = f2bf(o[d0][r] * rli[r]); }
      LDS_WAIT();
#pragma unroll
      for (int i = 0; i < 4; ++i) { const int row = i * 8 + (lane >> 3), ch = lane & 7; const u32x4 v = *(const LAS u32x4*)(stg + row * 64 + ch * 8);
          bf16_t* gp = Yw + (long)row * YLD + ch * 8; const u32x4 gt = *(const u32x4*)gp; u32x4 w;
          w.x = cvtpk(bf_lo(v.x) * bf_lo(gt.x), bf_hi(v.x) * bf_hi(gt.x)); w.y = cvtpk(bf_lo(v.y) * bf_lo(gt.y), bf_hi(v.y) * bf_hi(gt.y));
          w.z = cvtpk(bf_lo(v.z) * bf_lo(gt.z), bf_hi(v.z) * bf_hi(gt.z)); w.w = cvtpk(bf_lo(v.w) * bf_lo(gt.w), bf_hi(v.w) * bf_hi(gt.w));
          *(u32x4*)gp = w; }
      LDS_WAIT(); }
#undef ATT_DMA
}
}

#define XB_TMO      128
#define XB_XCNT(j)  (256  + 64 * (j))
#define XB_XSUB(j)  (1280 + 64 * (j))
#define XB_XGEN(j)  (2304 + 64 * (j))
#define XB_TOP      3328
#define XB_TOPGEN   3392
#define XCD_BAR_WORDS 3456
#define XB_SPIN_CAP (1u << 18)
__device__ __forceinline__ unsigned xb_ld(unsigned* p)              { return __hip_atomic_load(p, __ATOMIC_RELAXED, __HIP_MEMORY_SCOPE_AGENT); }
__device__ __forceinline__ unsigned xb_add(unsigned* p, unsigned v) { return __hip_atomic_fetch_add(p, v, __ATOMIC_RELAXED, __HIP_MEMORY_SCOPE_AGENT); }
__device__ __forceinline__ unsigned xb_xcc_id() { return (unsigned)__builtin_amdgcn_s_getreg((3 << 11) | 20) & 0xFu; }
#define XB_SPIN(cond, bar) do { unsigned _sp = 0; while (cond) { __builtin_amdgcn_s_sleep(1); \
    if ((++_sp & 255u) == 0u) { if (xb_ld(&(bar)[XB_TMO])) break; if (_sp > XB_SPIN_CAP) { atomicAdd(&(bar)[XB_TMO], 1u); break; } } } } while (0)
struct XcdBarrier { unsigned* bar; unsigned x; volatile LAS unsigned* st; };
__device__ __forceinline__ XcdBarrier xcd_barrier_post(unsigned* bar, volatile LAS unsigned* st) {
    XcdBarrier b; b.bar = bar; b.x = xb_xcc_id(); b.st = st;
    if (threadIdx.x == 0) (void)xb_add(&bar[XB_XCNT(b.x)], 1u);
    return b;
}
__device__ __forceinline__ void xcd_barrier_complete(unsigned* bar, unsigned x, unsigned& nloc, unsigned& nx) {
    const unsigned G = gridDim.x * gridDim.y * gridDim.z;
    unsigned sum, cnt, mine, sp = 0u;
    for (;;) {
        sum = 0u; cnt = 0u; mine = 0u;
#pragma unroll
        for (unsigned j = 0; j < 16; ++j) { const unsigned c = xb_ld(&bar[XB_XCNT(j)]); sum += c; cnt += (c > 0u) ? 1u : 0u; mine = (j == x) ? c : mine; }
        if (sum == G) break;
        __builtin_amdgcn_s_sleep(1);
        if ((++sp & 255u) == 0u) { if (xb_ld(&bar[XB_TMO])) break; if (sp > XB_SPIN_CAP) { atomicAdd(&bar[XB_TMO], 1u); break; } }
    }
    nloc = mine > 0u ? mine : 1u; nx = cnt > 0u ? cnt : 1u;
}
__device__ __forceinline__ void xcd_barrier(const XcdBarrier& b) {
    asm volatile("s_waitcnt vmcnt(0)" ::: "memory");
    __syncthreads();
    if (threadIdx.x == 0) {
        unsigned* bar = b.bar;
        __builtin_amdgcn_s_waitcnt(0);
        unsigned nloc = b.st[0], nx = b.st[1];
        if (nloc == 0u) { xcd_barrier_complete(bar, b.x, nloc, nx); b.st[0] = nloc; b.st[1] = nx; }
        const unsigned old = xb_add(&bar[XB_XSUB(b.x)], 1u);
        const unsigned gen = old / nloc;
        if (old + 1u == (gen + 1u) * nloc) {
            __builtin_amdgcn_fence(__ATOMIC_RELEASE, "agent");
            asm volatile("s_waitcnt vmcnt(0)" ::: "memory");
            const unsigned og = xb_add(&bar[XB_TOP], 1u);
            const unsigned tg = og / nx;
            if (og + 1u == (tg + 1u) * nx) xb_add(&bar[XB_TOPGEN], 1u);
            else XB_SPIN(xb_ld(&bar[XB_TOPGEN]) == tg, bar);
            __builtin_amdgcn_fence(__ATOMIC_ACQUIRE, "agent");
            xb_add(&bar[XB_XGEN(b.x)], 1u);
            asm volatile("s_waitcnt vmcnt(0)" ::: "memory");
        } else {
            XB_SPIN(xb_ld(&bar[XB_XGEN(b.x)]) == gen, bar);
            __builtin_amdgcn_fence(__ATOMIC_ACQUIRE, "agent");
            asm volatile("s_waitcnt vmcnt(0)" ::: "memory");
        }
    }
    __syncthreads();
}

constexpr int NWAVES = 8;
constexpr int RING_BYTES = 131072, LDSCTL_OFF = RING_BYTES, MISC_OFF = LDSCTL_OFF + 320, LDS_BYTES = 147456;
static_assert(att::LDS_BYTES <= RING_BYTES, "attention scratch fits the ring region");

template <class F> __device__ __forceinline__ void transpose_item(const float* W, int ldw, bf16_t* WT, int ldwt, LAS float* scr, int k0, int n0, int lane, F scol) {
    const int sc = scol(n0 + (lane & 31));
#pragma unroll 8
    for (int i = 0; i < 32; ++i) { const int kk = 2 * i + (lane >> 5); scr[kk * 33 + (lane & 31)] = sc >= 0 ? W[(size_t)(k0 + kk) * ldw + sc] : 0.f; }
    LDS_WAIT(); asm volatile("" ::: "memory");
    const int c = lane & 7;
#pragma unroll
    for (int j = 0; j < 4; ++j) { const int n = (lane >> 3) + 8 * j; const LAS float* s = scr + (8 * c) * 33 + n;
        u32x4 o; o.x = cvtpk(s[0 * 33], s[1 * 33]); o.y = cvtpk(s[2 * 33], s[3 * 33]); o.z = cvtpk(s[4 * 33], s[5 * 33]); o.w = cvtpk(s[6 * 33], s[7 * 33]);
        *(u32x4*)(WT + (size_t)(n0 + n) * ldwt + k0 + 8 * c) = o; }
    LDS_WAIT(); asm volatile("" ::: "memory");
}
__device__ __forceinline__ int win_scol(int n) {
    if (n < 512) return n;
    if (n < 768) return 1024 + (n - 512);
    if (n < 896) return 1280 + (n - 768);
    if (n < 928) return 1408 + (n - 896);
    if (n < 1024) return -1;
    if (n < 1536) return 1952 + (n - 1024);
    if (n < 2048) return 2464 + (n - 1536);
    if (n < 2560) return 512 + (n - 2048);
    if (n < 3072) return 1440 + (n - 2560);
    if (n < 3584) return 2976 + (n - 3072);
    return 3488 + (n - 3584);
}
__device__ __forceinline__ int wuq_scol(int n) { const int h = n / 96, d = n - h * 96; return h * 96 + (d < 64 ? d : 64 + ((d - 64) >> 1) + 16 * ((d - 64) & 1)); }

__device__ __forceinline__ void rms_row_to_bf16(const float* xrow, const float* g, bf16_t* orow, int lane) {
    const f32x4* xr = (const f32x4*)xrow + lane; f32x4 v[4]; float s = 0.f;
#pragma unroll
    for (int j = 0; j < 4; ++j) { v[j] = xr[64 * j]; s += (v[j].x * v[j].x + v[j].y * v[j].y) + (v[j].z * v[j].z + v[j].w * v[j].w); }
    const float rstd = 1.f / sqrtf(wave_sum(s) * (1.f / DM) + EPS);
    u32x2* o8 = (u32x2*)orow + lane;
#pragma unroll
    for (int j = 0; j < 4; ++j) { const f32x4 gg = ((const f32x4*)g)[lane + 64 * j]; u32x2 w; w.x = cvtpk(v[j].x * rstd * gg.x, v[j].y * rstd * gg.y); w.y = cvtpk(v[j].z * rstd * gg.z, v[j].w * rstd * gg.w); o8[64 * j] = w; }
}

struct Args { const void* in[20]; float* out; unsigned char* ws; int ph_lo, ph_hi, li, pad; };
constexpr int N_PHASES = 1 + 8 * DEPTH;

__global__ void __launch_bounds__(NWAVES * 64, 2) hybrid_fwd(Args args) {
    extern __shared__ __attribute__((aligned(16))) unsigned char lds_raw[];
    LAS unsigned char* lds = (LAS unsigned char*)lds_raw;
    volatile LAS unsigned* MISC = (volatile LAS unsigned*)(lds + MISC_OFF);
    const int G = gridDim.x, bx = blockIdx.x, vcu = (G % 8 == 0) ? (bx % 8) * (G / 8) + bx / 8 : bx;
#define LOAD_TID int tid = threadIdx.x; asm volatile("" : "+v"(tid)); const int lane = tid & 63, wave = __builtin_amdgcn_readfirstlane(tid >> 6); const int gw = vcu * NWAVES + wave, NGW = G * NWAVES; (void)lane; (void)gw; (void)NGW
    typedef __attribute__((address_space(4))) const Args* KArgs;
#define LOAD_PTRS \
    KArgs ap = (KArgs)__builtin_amdgcn_kernarg_segment_ptr(); asm volatile("" : "+s"(ap)); \
    unsigned char* ws = ap->ws; float* out = ap->out; \
    const float* x_in = (const float*)ap->in[0]; const int* positions = (const int*)ap->in[1]; \
    const float* norm_pre = (const float*)ap->in[2]; const float* norm_post = (const float*)ap->in[3]; \
    const float* w_in = (const float*)ap->in[4]; const float* b_gate = (const float*)ap->in[5]; \
    const float* pool_w = (const float*)ap->in[6]; const float* pool_scale = (const float*)ap->in[7]; \
    const float* q_norm = (const float*)ap->in[8]; const float* w_uq = (const float*)ap->in[9]; \
    const float* kv_norm = (const float*)ap->in[10]; const float* w_ukv = (const float*)ap->in[11]; \
    const float* v_norm_g = (const float*)ap->in[12]; const float* v_norm_b = (const float*)ap->in[13]; \
    const float* w_s = (const float*)ap->in[14]; const float* b_s = (const float*)ap->in[15]; \
    const float* w_oa = (const float*)ap->in[16]; const float* w_ob = (const float*)ap->in[17]; const float* w_oc = (const float*)ap->in[18]; \
    const float* w_out = (const float*)ap->in[19]; \
    float* CS = (float*)(ws + WS_CS); \
    bf16_t* Hb = (bf16_t*)(ws + WS_H); bf16_t* PROJ = (bf16_t*)(ws + WS_PROJ); bf16_t* GATES = (bf16_t*)(ws + WS_PROJ); float* Z = (float*)(ws + WS_PROJ); \
    bf16_t* Qb = (bf16_t*)(ws + WS_Q); bf16_t* Kb = (bf16_t*)(ws + WS_K); bf16_t* Vb = (bf16_t*)(ws + WS_V); bf16_t* Yb = (bf16_t*)(ws + WS_Y); \
    unsigned char* wl = ws + WS_W + (size_t)l * W_LAYER; const bf16_t* Win_t = (const bf16_t*)(wl + W_IN); const float* x_prev = l == 0 ? x_in : out; \
    (void)positions; (void)norm_pre; (void)norm_post; (void)w_in; (void)b_gate; (void)pool_w; (void)pool_scale; (void)q_norm; (void)w_uq; (void)kv_norm; (void)w_ukv; (void)v_norm_g; (void)v_norm_b; \
    (void)w_s; (void)b_s; (void)w_oa; (void)w_ob; (void)w_oc; (void)w_out; (void)CS; (void)Hb; (void)PROJ; (void)GATES; (void)Z; (void)Qb; (void)Kb; (void)Vb; (void)Yb; (void)Win_t; (void)x_prev; (void)x_in; (void)out
    unsigned* ctl = (unsigned*)(args.ws + WS_CTL);
    for (int u = threadIdx.x; u < (LDS_BYTES - LDSCTL_OFF) / 4; u += NWAVES * 64) ((LAS unsigned*)(lds + LDSCTL_OFF))[u] = 0u;
    __syncthreads();
    XcdBarrier bar; bar.bar = ctl + CW_BAR; bar.x = 0; bar.st = nullptr;
#if MK_SINGLE
    bar = xcd_barrier_post(ctl + CW_BAR, MISC + 8);
#define GRID_BAR() xcd_barrier(bar)
#else
    (void)MISC; (void)bar;
#define GRID_BAR() do { } while (0)
#endif
    const int lo = args.ph_lo, hi = args.ph_hi;
#ifdef ONLYP
#define IN(k) ((((k) - 1) & 7) + 1 == ONLYP && (k) > 0 && lo <= (k) && (k) < hi || (ONLYP == 0 && (k) == 0 && lo == 0))
#else
#define IN(k) (lo <= (k) && (k) < hi)
#endif
#define SEAM(k) do { if (IN(k) && IN((k) + 1)) GRID_BAR(); } while (0)

    if (IN(0)) {
        const int l = 0; LOAD_PTRS; LOAD_TID;
        LAS float* scr = (LAS float*)(lds + wave * 16384);
        constexpr int I_IN = 16 * (NIN / 32), I_UQ = 4 * 24, I_UKV = 2 * 32, I_POOL = 4 * 2 * 4, I_O = 8 * 32, I_OUT = 16 * 32;
        constexpr int I_LAYER = I_IN + I_UQ + I_UKV + I_POOL + 3 * I_O + I_OUT;
        for (int it = gw; it < DEPTH * I_LAYER; it += NGW) {
            const int l = it / I_LAYER; int r = it - l * I_LAYER;
            unsigned char* wl = ws + WS_W + (size_t)l * W_LAYER;
            if (r < I_IN) { const int nb = r % (NIN / 32), kb = r / (NIN / 32);
                transpose_item(w_in + (size_t)l * DM * 6560, 6560, (bf16_t*)(wl + W_IN), 1024, scr, 64 * kb, 32 * nb, lane, [](int n) { return win_scol(n); }); continue; } r -= I_IN;
            if (r < I_UQ) { const int nb = r % 24, kb = r / 24;
                transpose_item(w_uq + (size_t)l * 256 * 768, 768, (bf16_t*)(wl + W_UQ), 256, scr, 64 * kb, 32 * nb, lane, [](int n) { return wuq_scol(n); }); continue; } r -= I_UQ;
            if (r < I_UKV) { const int nb = r % 32, kb = r / 32;
                transpose_item(w_ukv + (size_t)l * 128 * 1024, 1024, (bf16_t*)(wl + W_UKV), 128, scr, 64 * kb, 32 * nb, lane, [](int n) { return n; }); continue; } r -= I_UKV;
            if (r < I_POOL) { const int g = r >> 3, kb = (r >> 2) & 1, nb = r & 3;
                bf16_t* dst = (bf16_t*)(wl + W_POOL) + (size_t)(g >> 1) * 65536 + (size_t)(128 * (g & 1)) * 256 + 128 * (g & 1);
                transpose_item(pool_w + (size_t)l * 65536 + (size_t)g * 16384, 128, dst, 256, scr, 64 * kb, 32 * nb, lane, [](int n) { return n; }); continue; } r -= I_POOL;
            if (r < 3 * I_O) { const int wsel = r / I_O, rr = r % I_O, nb = rr % 32, kb = rr / 32; const float* src = wsel == 0 ? w_oa : wsel == 1 ? w_ob : w_oc;
                transpose_item(src + (size_t)l * 512 * 1024, 1024, (bf16_t*)(wl + W_OA) + (size_t)wsel * 1024 * 512, 512, scr, 64 * kb, 32 * nb, lane, [](int n) { return n; }); continue; } r -= 3 * I_O;
            { const int nb = r % 32, kb = r / 32;
                transpose_item(w_out + (size_t)l * 1024 * 1024, 1024, (bf16_t*)(wl + W_OUT), 1024, scr, 64 * kb, 32 * nb, lane, [](int n) { return n; }); }
        }
        const int gt = vcu * 512 + tid, NGT = G * 512;
        for (int i = gt; i < DEPTH * 2 * 2 * 16384; i += NGT) { const int l = i / 65536, r = i % 65536, pr = r / 32768, ob = (r / 16384) & 1, e = r % 16384, rr = e / 128, cc = e % 128;
            bf16_t* dst = (bf16_t*)(ws + WS_W + (size_t)l * W_LAYER + W_POOL) + (size_t)pr * 65536; dst[(size_t)(128 * ob + rr) * 256 + 128 * (1 - ob) + cc] = 0; }
        for (int i = gt; i < DEPTH * 8 * 16384; i += NGT) { const int l = i / 131072, r = i % 131072, e = r % 16384, t = e / 128, s = e % 128;
            ((bf16_t*)(ws + WS_W + (size_t)l * W_LAYER + W_S))[r] = f2bf(s <= t ? w_s[i] : 0.f); }
        for (int i = gt; i < M * 16; i += NGT) { const int row = i >> 4, j = i & 15; const float inv = powf(10000.f, -(float)(2 * j) / 32.f); const float ang = (float)positions[row] * inv;
            float sn, cn; sincosf(ang, &sn, &cn); CS[(size_t)row * 32 + 2 * j] = cn; CS[(size_t)row * 32 + 2 * j + 1] = sn; }
        for (int m = gw; m < M; m += NGW) rms_row_to_bf16(x_in + (size_t)m * DM, norm_pre, Hb + (size_t)m * DM, lane);
    }
    SEAM(0);

#pragma unroll 1
    for (int l = 0; l < DEPTH; ++l) {
        const int pb = 1 + 8 * l;

        if (IN(pb + 0)) {
            LOAD_PTRS; LOAD_TID;
            pg8::Prob P{}; P.A = Hb; P.Bt = Win_t; P.lda = DM; P.ldb = DM; P.K = DM; P.T.init(M, NPROJ, G, bx); P.nbr = 1;
            pg8::EpiProj E{PROJ, Yb};
            pg8::gemm_phase<pg8::EpiProj, true, true>(lds, P, E);
        }
        SEAM(pb + 0);

        if (IN(pb + 1)) {
            LOAD_PTRS; LOAD_TID;
            const float* qn = q_norm + l * 256; const float* kn = kv_norm + l * 128; const float* vg = v_norm_g + l * 512; const float* vb = v_norm_b + l * 512;
            for (int m = gw; m < M; m += NGW) {
                bf16_t* pr = PROJ + (size_t)m * PLD;
                { u32x2* p = (u32x2*)(pr + 512) + lane; const u32x2 w = *p; float a = bf_lo(w.x), b = bf_hi(w.x), c = bf_lo(w.y), d = bf_hi(w.y);
                  const float rstd = 1.f / sqrtf(wave_sum(a * a + b * b + c * c + d * d) * (1.f / 256.f) + EPS); const f32x4 g = ((const f32x4*)qn)[lane];
                  u32x2 o; o.x = cvtpk(a * rstd * g.x, b * rstd * g.y); o.y = cvtpk(c * rstd * g.z, d * rstd * g.w); *p = o; }
                { unsigned* p = (unsigned*)(pr + 768) + lane; const unsigned w = *p; float a = bf_lo(w), b = bf_hi(w);
                  const float rstd = 1.f / sqrtf(wave_sum(a * a + b * b) * (1.f / 128.f) + EPS); const f32x2 g = ((const f32x2*)kn)[lane];
                  *p = cvtpk(a * rstd * g.x, b * rstd * g.y); }
                if (lane < 16) { const float x1 = bf2f(pr[896 + lane]), x2 = bf2f(pr[912 + lane]); const f32x2 cs = ((const f32x2*)(CS + (size_t)m * 32))[lane];
                  const unsigned w = cvtpk(x1 * cs.x - x2 * cs.y, x2 * cs.x + x1 * cs.y);
#pragma unroll
                  for (int h = 0; h < 8; ++h) ((unsigned*)(Kb + (size_t)m * QLD + h * 96 + 64))[lane] = w; }
                { u32x4* p = (u32x4*)(pr + 1536) + lane; const u32x4 w = *p; float f[8] = {bf_lo(w.x), bf_hi(w.x), bf_lo(w.y), bf_hi(w.y), bf_lo(w.z), bf_hi(w.z), bf_lo(w.w), bf_hi(w.w)};
                  float s = 0.f;
#pragma unroll
                  for (int e = 0; e < 8; ++e) s += f[e];
                  const float mean = wave_sum(s) * (1.f / 512.f); float s2 = 0.f;
#pragma unroll
                  for (int e = 0; e < 8; ++e) { f[e] -= mean; s2 += f[e] * f[e]; }
                  const float rstd = 1.f / sqrtf(wave_sum(s2) * (1.f / 512.f) + EPS);
                  const f32x4 g0 = ((const f32x4*)vg)[2 * lane], g1 = ((const f32x4*)vg)[2 * lane + 1], b0 = ((const f32x4*)vb)[2 * lane], b1 = ((const f32x4*)vb)[2 * lane + 1];
                  u32x4 o; o.x = cvtpk(f[0] * rstd * g0.x + b0.x, f[1] * rstd * g0.y + b0.y); o.y = cvtpk(f[2] * rstd * g0.z + b0.z, f[3] * rstd * g0.w + b0.w);
                  o.z = cvtpk(f[4] * rstd * g1.x + b1.x, f[5] * rstd * g1.y + b1.y); o.w = cvtpk(f[6] * rstd * g1.z + b1.z, f[7] * rstd * g1.w + b1.w); *p = o; }
            }
        }
        SEAM(pb + 1);

        if (IN(pb + 2)) {
            LOAD_PTRS; LOAD_TID;
#ifndef P2BM
#define P2BM 15
#endif
            if (P2BM & 1) { pg8::Prob P{}; P.A = PROJ; P.Bt = (const bf16_t*)(wl + W_UQ); P.lda = PLD; P.ldb = 256; P.K = 256; P.T.init(M, 768, G, bx); P.a_col0 = 512; P.nbr = 1;
              pg8::EpiQ E{Qb, CS}; pg8::gemm_phase<pg8::EpiQ, true, true>(lds, P, E); }
            if (P2BM & 2) { pg8::Prob P{}; P.A = PROJ; P.Bt = (const bf16_t*)(wl + W_UKV); P.lda = PLD; P.ldb = 128; P.K = 128; P.T.init(M, 1024, G, bx); P.a_col0 = 768; P.nbr = 1;
              pg8::EpiKV E{Kb, Vb}; pg8::gemm_phase<pg8::EpiKV, true, true>(lds, P, E); }
            if (P2BM & 4) { pg8::Prob P{}; P.A = PROJ; P.Bt = (const bf16_t*)(wl + W_POOL); P.lda = PLD; P.ldb = 256; P.K = 256; P.T.init(M, 512, G, (bx + G / 2) % G); P.a_col0 = 0; P.a_col_per_pn = 256; P.nbr = 1;
              pg8::EpiPlain E{PROJ, PLD}; pg8::gemm_phase<pg8::EpiPlain, true, true>(lds, P, E); }
            __syncthreads();
            const bf16_t* Wsb = (const bf16_t*)(wl + W_S);
            if (P2BM & 8) for (int ch = vcu; ch < M / 128; ch += G) {
                const int g = wave; LAS unsigned char* img = lds + g * 16384;
                const bf16_t* vsrc = PROJ + (size_t)(ch * 128) * PLD + 1536 + 64 * g;
#pragma unroll
                for (int hh = 0; hh < 2; ++hh)
#pragma unroll
                    for (int i = 0; i < 8; ++i) { const int row = 16 * i + (lane >> 2);
                        const u32x4 w = *(const u32x4*)(vsrc + (size_t)row * PLD + 32 * hh + (lane & 3) * 8);
                        *(LAS u32x4*)(img + hh * 8192 + row * 64 + (lane & 3) * 16) = w; }
                LDS_WAIT();
                const int r32 = lane & 31, hi = lane >> 5;
                const att::lds_cptr vp = (att::lds_cptr)img + (8 * hi + ((lane & 15) >> 2)) * 64 + ((lane >> 4) & 1) * 32 + (lane & 3) * 8;
                const bf16_t* wg = Wsb + (size_t)g * 16384;
                const float* bs = b_s + (size_t)l * 1024 + g * 128;
#pragma unroll 1
                for (int ti = 0; ti < 4; ++ti) {
                    f32x16 a0 = f32x16{}, a1 = f32x16{};
                    for (int ks = 0; ks <= 2 * ti + 1; ++ks) {
                        const bf16x8 af = *(const bf16x8*)(wg + (size_t)(32 * ti + r32) * 128 + 16 * ks + 8 * hi);
                        const s16x4 l0 = att::vtr(vp + ks * 1024), h0 = att::vtr(vp + ks * 1024 + 256), l1 = att::vtr(vp + 8192 + ks * 1024), h1 = att::vtr(vp + 8192 + ks * 1024 + 256);
                        const bf16x8 b0 = (bf16x8){l0[0], l0[1], l0[2], l0[3], h0[0], h0[1], h0[2], h0[3]}, b1 = (bf16x8){l1[0], l1[1], l1[2], l1[3], h1[0], h1[1], h1[2], h1[3]};
                        a0 = __builtin_amdgcn_mfma_f32_32x32x16_bf16(af, b0, a0, 0, 0, 0);
                        a1 = __builtin_amdgcn_mfma_f32_32x32x16_bf16(af, b1, a1, 0, 0, 0);
                    }
#pragma unroll
                    for (int r = 0; r < 16; ++r) { const int t = 32 * ti + att::crow(r, hi); const size_t row = (size_t)(ch * 128 + t); const float bb = bs[t];
                        const bf16_t* up = PROJ + row * PLD + 1024 + 64 * g + r32; bf16_t* yp = Yb + row * YLD + 1024 + 64 * g + r32;
                        yp[0] = f2bf(bf2f(up[0]) * (a0[r] + bb) * bf2f(yp[0])); yp[32] = f2bf(bf2f(up[32]) * (a1[r] + bb) * bf2f(yp[32])); }
                }
                LDS_WAIT();
            }
        }
        SEAM(pb + 2);

        if (IN(pb + 3)) {
            LOAD_PTRS; LOAD_TID;
            const float* psc = pool_scale + l * 512;
            for (int st = vcu; st < M / 64; st += G) {
                const int cp = tid & 255, sub = tid >> 8, c0 = 2 * cp, w = 2 << (c0 >> 7);
                const int t0 = st * 64 + sub * 32; const float sc0 = psc[c0], sc1 = psc[c0 + 1];
                float s0 = 0.f, s1 = 0.f;
                for (int j = 1; j < w; ++j) { const int t = t0 - j; if ((t0 & (SEQ - 1)) - j >= 0) { const unsigned v = *(const unsigned*)(PROJ + (size_t)t * PLD + c0); s0 += bf_lo(v); s1 += bf_hi(v); } }
                for (int i = 0; i < 32; ++i) { const int t = t0 + i, tau = t & (SEQ - 1);
                    const unsigned v = *(const unsigned*)(PROJ + (size_t)t * PLD + c0); const float p0 = bf_lo(v), p1 = bf_hi(v);
                    s0 += p0; s1 += p1;
                    const float inv = 1.f / (float)(tau + 1 < w ? tau + 1 : w);
                    unsigned* yp = (unsigned*)(Yb + (size_t)t * YLD + c0); const unsigned gt = *yp;
                    *yp = cvtpk((s0 * inv - p0) * sc0 * bf_lo(gt), (s1 * inv - p1) * sc1 * bf_hi(gt));
                    if (tau - (w - 1) >= 0) { const unsigned vo = *(const unsigned*)(PROJ + (size_t)(t - (w - 1)) * PLD + c0); s0 -= bf_lo(vo); s1 -= bf_hi(vo); } }
            }
            __syncthreads();
            const unsigned lds0 = (unsigned)(uintptr_t)lds_raw;
            for (int k = vcu; k < 512; k += G) { const int p = k & 255, bh = p >> 4, s = p & 15; const int qb = k < 256 ? s : 31 - s;
                att::attn_unit(bh >> 3, bh & 7, qb, Qb, Kb, Vb, Yb, (LAS char*)lds, lds0); }
            __syncthreads();
        }
        SEAM(pb + 3);

        if (IN(pb + 4)) {
            LOAD_PTRS; LOAD_TID;
            pg8::Prob P{}; P.A = Hb; P.Bt = Win_t + (size_t)NPROJ * DM; P.lda = DM; P.ldb = DM; P.K = DM; P.T.init(M, NGATE, G, bx); P.nbr = 1;
            pg8::EpiGate E{GATES, b_gate + l * NGATE};
            pg8::gemm_phase<pg8::EpiGate, true, true>(lds, P, E);
        }
        SEAM(pb + 4);

        if (IN(pb + 5)) {
            LOAD_PTRS; LOAD_TID;
            pg8::Prob P{}; P.A = Yb; P.Bt = (const bf16_t*)(wl + W_OA); P.lda = YLD; P.ldb = 512; P.K = 512; P.T.init(M, DM, G, bx); P.nbr = 3; P.a_col_per_br = 512; P.b_per_br = (size_t)1024 * 512;
            pg8::EpiMerge E{GATES, Hb};
            pg8::gemm_phase<pg8::EpiMerge, false, true>(lds, P, E);
        }
        SEAM(pb + 5);

        if (IN(pb + 6)) {
            LOAD_PTRS; LOAD_TID;
            pg8::Prob P{}; P.A = Hb; P.Bt = (const bf16_t*)(wl + W_OUT); P.lda = DM; P.ldb = DM; P.K = DM; P.T.init(M, DM, G, bx); P.nbr = 1;
            pg8::EpiZ E{Z};
            pg8::gemm_phase<pg8::EpiZ, false, true>(lds, P, E);
        }
        SEAM(pb + 6);

        if (IN(pb + 7)) {
            LOAD_PTRS; LOAD_TID;
            const float* gp = norm_post + l * DM; const float* gn = norm_pre + (l + 1 < DEPTH ? l + 1 : l) * DM;
            for (int m = gw; m < M; m += NGW) {
                const f32x4* zr = (const f32x4*)(Z + (size_t)m * DM) + lane; const f32x4* xr = (const f32x4*)(x_prev + (size_t)m * DM) + lane; f32x4* orow = (f32x4*)(out + (size_t)m * DM) + lane;
                f32x4 v[4]; float s = 0.f;
#pragma unroll
                for (int j = 0; j < 4; ++j) { v[j] = zr[64 * j]; s += (v[j].x * v[j].x + v[j].y * v[j].y) + (v[j].z * v[j].z + v[j].w * v[j].w); }
                const float rstd = 1.f / sqrtf(wave_sum(s) * (1.f / DM) + EPS); float s2 = 0.f;
#pragma unroll
                for (int j = 0; j < 4; ++j) { const f32x4 g = ((const f32x4*)gp)[lane + 64 * j]; v[j] = xr[64 * j] + v[j] * rstd * g; orow[64 * j] = v[j];
                    s2 += (v[j].x * v[j].x + v[j].y * v[j].y) + (v[j].z * v[j].z + v[j].w * v[j].w); }
                if (l + 1 < DEPTH) { const float r2 = 1.f / sqrtf(wave_sum(s2) * (1.f / DM) + EPS); u32x2* o8 = (u32x2*)(Hb + (size_t)m * DM) + lane;
#pragma unroll
                    for (int j = 0; j < 4; ++j) { const f32x4 g = ((const f32x4*)gn)[lane + 64 * j]; u32x2 w; w.x = cvtpk(v[j].x * r2 * g.x, v[j].y * r2 * g.y); w.y = cvtpk(v[j].z * r2 * g.z, v[j].w * r2 * g.w); o8[64 * j] = w; } }
            }
        }
        if (l + 1 < DEPTH) SEAM(pb + 7);
    }
#undef IN
#undef SEAM
}

extern "C" void kernel_launch(void* const* d_in, const int* in_sizes, int n_in, void* d_out, int out_size, void* d_ws, size_t ws_size, hipStream_t stream) {
    static int grid = 0;
    if (grid == 0) {
        if (n_in != 20 || out_size != M * DM || ws_size < WS_END) { fprintf(stderr, "kernel_launch: unexpected shapes (n_in %d out %d ws %zu)\n", n_in, out_size, ws_size); grid = -1; return; }
        int dev = 0, cus = 0, per_cu = 0;
        if (hipGetDevice(&dev) != hipSuccess || hipDeviceGetAttribute(&cus, hipDeviceAttributeMultiprocessorCount, dev) != hipSuccess) { grid = -1; return; }
        if (hipFuncSetAttribute((const void*)hybrid_fwd, hipFuncAttributeMaxDynamicSharedMemorySize, LDS_BYTES) != hipSuccess) { fprintf(stderr, "kernel_launch: hipFuncSetAttribute failed\n"); grid = -1; return; }
        if (hipOccupancyMaxActiveBlocksPerMultiprocessor(&per_cu, (const void*)hybrid_fwd, NWAVES * 64, LDS_BYTES) != hipSuccess || per_cu < 1) { fprintf(stderr, "kernel_launch: occupancy query says %d\n", per_cu); per_cu = 1; }
        (void)hipGetLastError();
        grid = cus;
    }
    if (grid < 0) return;
    (void)hipMemsetAsync((char*)d_ws + WS_CTL, 0, CTL_ZERO_BYTES, stream);
    Args a{};
    for (int i = 0; i < 20; ++i) a.in[i] = d_in[i];
    a.out = (float*)d_out; a.ws = (unsigned char*)d_ws;
#if MK_SINGLE
    a.ph_lo = 0; a.ph_hi = N_PHASES; a.li = 0;
    hipLaunchKernelGGL(hybrid_fwd, dim3(grid), dim3(NWAVES * 64), LDS_BYTES, stream, a);
#else
    for (int p = 0; p < N_PHASES; ++p) { a.ph_lo = p; a.ph_hi = p + 1; a.li = p; hipLaunchKernelGGL(hybrid_fwd, dim3(grid), dim3(NWAVES * 64), LDS_BYTES, stream, a); }
#endif
}
```

```cpp
#include <hip/hip_runtime.h>
#include <hip/hip_bf16.h>
#include <cstdio>
#include <cstdint>
#include <cmath>

#ifndef MK_SINGLE
#define MK_SINGLE 1
#endif

#define LAS __attribute__((address_space(3)))
#define GAS __attribute__((address_space(1)))
typedef unsigned short bf16_t;
typedef short bf16x8 __attribute__((ext_vector_type(8)));
typedef short s16x4 __attribute__((ext_vector_type(4)));
typedef float f32x4 __attribute__((ext_vector_type(4)));
typedef float f32x2 __attribute__((ext_vector_type(2)));
typedef float f32x16 __attribute__((ext_vector_type(16)));
typedef unsigned u32x4 __attribute__((ext_vector_type(4)));
typedef unsigned u32x2 __attribute__((ext_vector_type(2)));
typedef __bf16 bf16x2_t __attribute__((ext_vector_type(2)));

constexpr int BATCH = 2, SEQ = 8192, DM = 1024, M = BATCH * SEQ, DEPTH = 2;
constexpr int NPROJ = 3584, NGATE = 3072, NIN = NPROJ + NGATE;
constexpr int PLD = 2048;
constexpr int YLD = 1536;
constexpr int QLD = 768, VLD = 512, GLD = 3072;
constexpr float EPS = 1e-6f;
constexpr float QSCALE = 0.10206207261596575f * 1.4426950408889634f;

constexpr size_t MiB = 1u << 20;
constexpr size_t WS_CTL = 0, CTL_ZERO_BYTES = 1 * MiB;
constexpr size_t WS_CS = 1 * MiB;
constexpr size_t WS_W = 3 * MiB, W_LAYER = 20 * MiB;
constexpr size_t W_IN = 0, W_UQ = 13 * MiB, W_UKV = 13 * MiB + 512 * 1024, W_POOL = 13 * MiB + 768 * 1024, W_S = 14 * MiB,
                 W_OA = 14 * MiB + 256 * 1024, W_OUT = 17 * MiB + 256 * 1024;
constexpr size_t WS_H = 43 * MiB;
constexpr size_t WS_PROJ = 75 * MiB;
constexpr size_t WS_Q = 139 * MiB, WS_K = 163 * MiB, WS_V = 187 * MiB;
constexpr size_t WS_Y = 203 * MiB;
constexpr size_t WS_END = 251 * MiB;
constexpr int CW_BAR = 4096;

__device__ __forceinline__ unsigned cvtpk(float lo, float hi) { f32x2 v = {lo, hi}; bf16x2_t b = __builtin_convertvector(v, bf16x2_t); return __builtin_bit_cast(unsigned, b); }
__device__ __forceinline__ float bf_lo(unsigned w) { return __uint_as_float(w << 16); }
__device__ __forceinline__ float bf_hi(unsigned w) { return __uint_as_float(w & 0xffff0000u); }
__device__ __forceinline__ float bf2f(bf16_t h) { return __uint_as_float(((unsigned)h) << 16); }
__device__ __forceinline__ bf16_t f2bf(float f) { return (bf16_t)(cvtpk(f, 0.f) & 0xffffu); }
__device__ __forceinline__ float sigmoid_f(float v) { return __builtin_amdgcn_rcpf(1.f + __builtin_amdgcn_exp2f(-1.4426950408889634f * v)); }
__device__ __forceinline__ float silu_f(float v) { return v * sigmoid_f(v); }
__device__ __forceinline__ float wave_sum(float v) {
#pragma unroll
    for (int o = 1; o < 64; o <<= 1) v += __shfl_xor(v, o);
    return v;
}
#define LDS_WAIT() asm volatile("s_waitcnt lgkmcnt(0)" ::: "memory")
#define VM_WAIT() asm volatile("s_waitcnt vmcnt(0)" ::: "memory")

namespace pg8 {
constexpr int BM = 256, BK = 64, HALF = 128, HTB = HALF * BK * 2, STAGE_BYTES = 8 * HTB, NXCD = 8, WGM = 8;
__host__ __device__ __forceinline__ int lds_byte(int r, int c) { const int st = (r >> 4) * 2 + (c >> 5), rr = r & 15, cc = c & 31, ob = rr * 64 + cc * 2; return st * 1024 + (ob ^ (((ob >> 9) & 1) << 5)); }
__host__ __device__ __forceinline__ void stage_rc(int b, int& R, int& C) { const int st = b / 1024, sb = b % 1024, swz = sb ^ (((sb >> 9) & 1) << 5); R = (st >> 1) * 16 + swz / 64; C = (st & 1) * 32 + (swz % 64) / 2; }
__host__ __device__ __forceinline__ int perm32(int rho) { const int n = rho >> 4, i = rho & 15; return 8 * (i >> 2) + 4 * n + (i & 3); }

struct Unit { int pm, pn, br; };
struct TileOrder {
    int nM, nN, nwg, G, c;
    __device__ __forceinline__ void init(int Mrows, int N, int G_, int c_) { nM = Mrows / BM; nN = N / BM; nwg = nM * nN; G = G_; c = c_; }
    __device__ __forceinline__ bool tile(int i, int& pm, int& pn) const {
        const long L = (long)i * G + c; if (L >= nwg) return false;
        int wgid = (int)L; { const int q = nwg / NXCD, r = nwg % NXCD, xcd = wgid % NXCD, off = wgid / NXCD; wgid = (xcd < r ? xcd * (q + 1) : r * (q + 1) + (xcd - r) * q) + off; }
        const int nig = WGM * nN, gid = wgid / nig, fm = gid * WGM, gsz = (nM - fm) < WGM ? (nM - fm) : WGM;
        pm = fm + ((wgid % nig) % gsz); pn = (wgid % nig) / gsz; return true;
    }
};
struct Prob {
    const bf16_t* A; const bf16_t* Bt; int lda, ldb, K; TileOrder T;
    int a_col_per_pn, a_col0;
    int a_col_per_br; size_t b_per_br; int nbr;
    __device__ __forceinline__ bool next(int i, Unit& u) const { const int ti = i / nbr; u.br = i - ti * nbr; return T.tile(ti, u.pm, u.pn); }
    __device__ __forceinline__ const char* aptr(const Unit& u) const { return (const char*)(A + (size_t)u.pm * BM * lda + a_col0 + a_col_per_pn * u.pn + a_col_per_br * u.br); }
    __device__ __forceinline__ const char* bptr(const Unit& u) const { return (const char*)(Bt + (size_t)u.pn * BM * ldb + b_per_br * u.br); }
};

template <class Epi, bool ALIGN_EPI, bool SP2>
__device__ __forceinline__ void gemm_phase(LAS unsigned char* lds, const Prob& P, const Epi& E) {
    int tid = threadIdx.x; asm volatile("" : "+v"(tid));
    const int wid = __builtin_amdgcn_readfirstlane(tid >> 6), lane = tid & 63, wr = wid >> 2, wc = wid & 3, fr = lane & 15, fq = lane >> 4;
    int nt = P.K / BK; asm volatile("" : "+s"(nt));
    unsigned voffA[2], voffB[2];
#pragma unroll
    for (int i = 0; i < 2; ++i) { int R, C; stage_rc(tid * 16 + i * 8192, R, C); const int Rb = Epi::PERM ? ((R & ~31) + perm32(R & 31)) : R;
        voffA[i] = (unsigned)(R * P.lda + C) * 2u; voffB[i] = (unsigned)(Rb * P.ldb + C) * 2u; }
    const size_t kstep = (size_t)(BK * 2);
    const size_t hstepA = (size_t)HALF * P.lda * 2, hstepB = (size_t)HALF * P.ldb * 2;
    const unsigned ldsw = (unsigned)wid * 1024u;
    const int aoff = lds_byte(wr * 64 + fr, fq * 8), boff = lds_byte(wc * 32 + fr, fq * 8);
#define PG8_SA(b, h) (((b) * 2 + (h)) * HTB)
#define PG8_SB(b, h) ((4 + (b) * 2 + (h)) * HTB)
#define PG8_STAGE(bufoff, gbase, voff) do { _Pragma("unroll") for (int _i = 0; _i < 2; ++_i) \
        __builtin_amdgcn_global_load_lds((const unsigned*)((const char*)(gbase) + (voff)[_i]), (LAS unsigned*)(lds + (bufoff) + ldsw + _i * 8192), 16, 0, 0); } while (0)
#define PG8_LDA(dst, b, h) do { _Pragma("unroll") for (int m = 0; m < 4; ++m) _Pragma("unroll") for (int k = 0; k < 2; ++k) dst[m][k] = *(const LAS bf16x8*)(lds + PG8_SA(b, h) + aoff + m * 2048 + k * 1024); } while (0)
#define PG8_LDB(dst, b, h) do { _Pragma("unroll") for (int n = 0; n < 2; ++n) _Pragma("unroll") for (int k = 0; k < 2; ++k) dst[n][k] = *(const LAS bf16x8*)(lds + PG8_SB(b, h) + boff + n * 2048 + k * 1024); } while (0)
#define PG8_MMA(ai, bj, At, Bt) do { __builtin_amdgcn_s_setprio(1); _Pragma("unroll") for (int m = 0; m < 4; ++m) _Pragma("unroll") for (int n = 0; n < 2; ++n) _Pragma("unroll") for (int k = 0; k < 2; ++k) \
        acc[ai][bj][m][n] = __builtin_amdgcn_mfma_f32_16x16x32_bf16(Bt[n][k], At[m][k], acc[ai][bj][m][n], 0, 0, 0); __builtin_amdgcn_s_setprio(0); } while (0)
#define PG8_WAIT_V(n) asm volatile("s_waitcnt vmcnt(" #n ")" ::: "memory")
#define PG8_WAIT_L(n) asm volatile("s_waitcnt lgkmcnt(" #n ")" ::: "memory")
#define PG8_BAR __builtin_amdgcn_s_barrier()
#define PG8_SCHED __builtin_amdgcn_sched_barrier(0)
    Unit cur, nxt; int ui = 0;
    if (!P.next(0, cur)) return;
    f32x4 acc[2][2][4][2];
#pragma unroll
    for (int a = 0; a < 2; ++a)
#pragma unroll
        for (int b = 0; b < 2; ++b)
#pragma unroll
            for (int m = 0; m < 4; ++m)
#pragma unroll
                for (int n = 0; n < 2; ++n) acc[a][b][m][n] = (f32x4){0.f, 0.f, 0.f, 0.f};
    bf16x8 At[4][2], B0[2][2], B1[2][2];
    const char* cA = P.aptr(cur); const char* cB = P.bptr(cur);
    if constexpr (SP2) {
        PG8_STAGE(PG8_SB(0, 0), cB, voffB); PG8_STAGE(PG8_SB(0, 1), cB + hstepB, voffB); PG8_STAGE(PG8_SA(0, 0), cA, voffA); PG8_STAGE(PG8_SA(0, 1), cA + hstepA, voffA);
        if (wr == 1) PG8_BAR;
        PG8_WAIT_V(2); PG8_BAR;
        PG8_STAGE(PG8_SB(1, 0), cB + kstep, voffB); PG8_STAGE(PG8_SA(1, 0), cA + kstep, voffA); PG8_STAGE(PG8_SB(1, 1), cB + hstepB + kstep, voffB);
        PG8_WAIT_V(6); PG8_BAR;
    } else {
        PG8_STAGE(PG8_SB(0, 0), cB, voffB); PG8_STAGE(PG8_SA(0, 0), cA, voffA); PG8_STAGE(PG8_SB(0, 1), cB + hstepB, voffB); PG8_STAGE(PG8_SA(0, 1), cA + hstepA, voffA);
        if (wr == 1) PG8_BAR;
        PG8_WAIT_V(4); PG8_BAR;
        PG8_STAGE(PG8_SB(1, 0), cB + kstep, voffB); PG8_STAGE(PG8_SA(1, 0), cA + kstep, voffA); PG8_STAGE(PG8_SB(1, 1), cB + hstepB + kstep, voffB);
        PG8_WAIT_V(6); PG8_BAR;
    }
    for (;;) {
        const bool has_next = P.next(ui + 1, nxt);
        const char* nA = has_next ? P.aptr(nxt) : cA; const char* nB = has_next ? P.bptr(nxt) : cB;
        for (int t = 0; t < nt; t += 2) {
            const bool last = (t == nt - 2);
            const char* a1 = cA + (size_t)(t + 1) * kstep;
            const char* a2 = last ? nA : cA + (size_t)(t + 2) * kstep; const char* b2 = last ? nB : cB + (size_t)(t + 2) * kstep;
            const char* a3 = a2 + kstep; const char* b3 = b2 + kstep;
            if constexpr (SP2) {
            PG8_LDB(B0, 0, 0); PG8_LDB(B1, 0, 1); PG8_SCHED; PG8_LDA(At, 0, 0); PG8_STAGE(PG8_SA(1, 1), a1 + hstepA, voffA);
            PG8_WAIT_V(8); PG8_WAIT_L(0); PG8_BAR; PG8_MMA(0, 0, At, B0); PG8_MMA(0, 1, At, B1); PG8_BAR; PG8_SCHED;
            PG8_LDA(At, 0, 1); PG8_STAGE(PG8_SB(0, 0), b2, voffB); PG8_STAGE(PG8_SB(0, 1), b2 + hstepB, voffB); PG8_STAGE(PG8_SA(0, 0), a2, voffA);
            PG8_WAIT_V(8); PG8_WAIT_L(0); PG8_BAR; PG8_MMA(1, 0, At, B0); PG8_MMA(1, 1, At, B1); PG8_BAR; PG8_SCHED;
            PG8_LDB(B0, 1, 0); PG8_LDB(B1, 1, 1); PG8_SCHED; PG8_LDA(At, 1, 0); PG8_STAGE(PG8_SA(0, 1), a2 + hstepA, voffA);
            PG8_WAIT_V(8); PG8_WAIT_L(0); PG8_BAR; PG8_MMA(0, 0, At, B0); PG8_MMA(0, 1, At, B1); PG8_BAR; PG8_SCHED;
            PG8_LDA(At, 1, 1); PG8_STAGE(PG8_SB(1, 0), b3, voffB); PG8_STAGE(PG8_SB(1, 1), b3 + hstepB, voffB); PG8_STAGE(PG8_SA(1, 0), a3, voffA);
            PG8_WAIT_V(8); PG8_WAIT_L(0); PG8_BAR; PG8_MMA(1, 0, At, B0); PG8_MMA(1, 1, At, B1); PG8_BAR; PG8_SCHED;
            } else {
            PG8_LDB(B0, 0, 0); PG8_SCHED; PG8_LDA(At, 0, 0); PG8_STAGE(PG8_SA(1, 1), a1 + hstepA, voffA);
            PG8_WAIT_L(8); PG8_BAR; PG8_WAIT_L(0); PG8_MMA(0, 0, At, B0); PG8_BAR; PG8_SCHED;
            PG8_LDB(B1, 0, 1); PG8_STAGE(PG8_SB(0, 0), b2, voffB);
            PG8_BAR; PG8_WAIT_L(0); PG8_MMA(0, 1, At, B1); PG8_BAR;
            PG8_LDA(At, 0, 1); PG8_STAGE(PG8_SA(0, 0), a2, voffA);
            PG8_BAR; PG8_WAIT_L(0); PG8_MMA(1, 0, At, B0); PG8_BAR; PG8_SCHED;
            PG8_STAGE(PG8_SB(0, 1), b2 + hstepB, voffB);
            PG8_WAIT_V(6); PG8_BAR; PG8_MMA(1, 1, At, B1); PG8_BAR;
            PG8_LDB(B0, 1, 0); PG8_SCHED; PG8_LDA(At, 1, 0); PG8_STAGE(PG8_SA(0, 1), a2 + hstepA, voffA);
            PG8_WAIT_L(8); PG8_BAR; PG8_WAIT_L(0); PG8_MMA(0, 0, At, B0); PG8_BAR; PG8_SCHED;
            PG8_LDB(B1, 1, 1); PG8_STAGE(PG8_SB(1, 0), b3, voffB);
            PG8_BAR; PG8_WAIT_L(0); PG8_MMA(0, 1, At, B1); PG8_BAR;
            PG8_LDA(At, 1, 1); PG8_STAGE(PG8_SA(1, 0), a3, voffA);
            PG8_BAR; PG8_WAIT_L(0); PG8_MMA(1, 0, At, B0); PG8_BAR; PG8_SCHED;
            PG8_STAGE(PG8_SB(1, 1), b3 + hstepB, voffB);
            PG8_WAIT_V(6); PG8_BAR; PG8_MMA(1, 1, At, B1); PG8_BAR;
            }
        }
        if constexpr (ALIGN_EPI) { if (wr == 0) PG8_BAR; }
        const bool keep = E(acc, cur, wr, wc, fr, fq);
        if (!has_next) break;
        if (!keep) {
#pragma unroll
        for (int a = 0; a < 2; ++a)
#pragma unroll
            for (int b = 0; b < 2; ++b)
#pragma unroll
                for (int m = 0; m < 4; ++m)
#pragma unroll
                    for (int n = 0; n < 2; ++n) acc[a][b][m][n] = (f32x4){0.f, 0.f, 0.f, 0.f};
        }
        cur = nxt; cA = nA; cB = nB; ++ui;
        if constexpr (ALIGN_EPI) { if (wr == 1) PG8_BAR; }
    }
    PG8_WAIT_V(0);
    if constexpr (!ALIGN_EPI) { if (wr == 0) PG8_BAR; }
    PG8_BAR;
#undef PG8_SA
#undef PG8_SB
#undef PG8_STAGE
#undef PG8_LDA
#undef PG8_LDB
#undef PG8_MMA
#undef PG8_WAIT_V
#undef PG8_WAIT_L
#undef PG8_BAR
#undef PG8_SCHED
}

typedef f32x4 Acc[2][2][4][2];
__device__ __forceinline__ void store8(bf16_t* p, f32x4 v0, f32x4 v1) { u32x4 w; w.x = cvtpk(v0[0], v0[1]); w.y = cvtpk(v0[2], v0[3]); w.z = cvtpk(v1[0], v1[1]); w.w = cvtpk(v1[2], v1[3]); *(u32x4*)p = w; }

struct EpiProj {
    static constexpr bool PERM = true;
    bf16_t* proj; bf16_t* y;
    __device__ __forceinline__ bool operator()(Acc& acc, const Unit& u, int wr, int wc, int fr, int fq) const {
        const bool act = u.pn >= 8;
        bf16_t* base = act ? y + (u.pn - 8) * 256 : proj + u.pn * 256; const int ld = act ? YLD : PLD;
        const int row0 = u.pm * BM + wr * 64 + fr, col0 = wc * 32 + 8 * fq;
#pragma unroll
        for (int ai = 0; ai < 2; ++ai)
#pragma unroll
            for (int m = 0; m < 4; ++m) { bf16_t* rowp = base + (size_t)(row0 + ai * HALF + m * 16) * ld + col0;
#pragma unroll
                for (int bj = 0; bj < 2; ++bj) { f32x4 v0 = acc[ai][bj][m][0], v1 = acc[ai][bj][m][1];
                    if (act) {
#pragma unroll
                        for (int e = 0; e < 4; ++e) { v0[e] = silu_f(v0[e]); v1[e] = silu_f(v1[e]); } }
                    store8(rowp + bj * HALF, v0, v1); } }
        return false;
    }
};
struct EpiGate {
    static constexpr bool PERM = true;
    bf16_t* g; const float* bias;
    __device__ __forceinline__ bool operator()(Acc& acc, const Unit& u, int wr, int wc, int fr, int fq) const {
        const int row0 = u.pm * BM + wr * 64 + fr, col0 = u.pn * BM + wc * 32 + 8 * fq;
        f32x4 bv[2][2];
#pragma unroll
        for (int bj = 0; bj < 2; ++bj)
#pragma unroll
            for (int n = 0; n < 2; ++n) bv[bj][n] = *(const f32x4*)(bias + col0 + bj * HALF + 4 * n);
#pragma unroll
        for (int ai = 0; ai < 2; ++ai)
#pragma unroll
            for (int m = 0; m < 4; ++m) { bf16_t* rowp = g + (size_t)(row0 + ai * HALF + m * 16) * GLD + col0;
#pragma unroll
                for (int bj = 0; bj < 2; ++bj) { f32x4 v0 = acc[ai][bj][m][0] + bv[bj][0], v1 = acc[ai][bj][m][1] + bv[bj][1];
#pragma unroll
                    for (int e = 0; e < 4; ++e) { v0[e] = sigmoid_f(v0[e]); v1[e] = sigmoid_f(v1[e]); }
                    store8(rowp + bj * HALF, v0, v1); } }
        return false;
    }
};
struct EpiQ {
    static constexpr bool PERM = true;
    bf16_t* q; const float* cs;
    __device__ __forceinline__ bool operator()(Acc& acc, const Unit& u, int wr, int wc, int fr, int fq) const {
        const int row0 = u.pm * BM + wr * 64 + fr, col0 = u.pn * BM + wc * 32 + 8 * fq;
#pragma unroll
        for (int ai = 0; ai < 2; ++ai)
#pragma unroll
            for (int m = 0; m < 4; ++m) { const int row = row0 + ai * HALF + m * 16; bf16_t* rowp = q + (size_t)row * QLD + col0;
#pragma unroll
                for (int bj = 0; bj < 2; ++bj) { f32x4 v0 = acc[ai][bj][m][0], v1 = acc[ai][bj][m][1];
                    const int d = (col0 + bj * HALF) % 96;
                    if (d >= 64) { const float* c = cs + (size_t)row * 32 + (d - 64); const f32x4 c0 = *(const f32x4*)c, c1 = *(const f32x4*)(c + 4);
                        f32x4 o0, o1;
                        o0[0] = v0[0] * c0[0] - v0[1] * c0[1]; o0[1] = v0[1] * c0[0] + v0[0] * c0[1];
                        o0[2] = v0[2] * c0[2] - v0[3] * c0[3]; o0[3] = v0[3] * c0[2] + v0[2] * c0[3];
                        o1[0] = v1[0] * c1[0] - v1[1] * c1[1]; o1[1] = v1[1] * c1[0] + v1[0] * c1[1];
                        o1[2] = v1[2] * c1[2] - v1[3] * c1[3]; o1[3] = v1[3] * c1[2] + v1[2] * c1[3];
                        v0 = o0; v1 = o1; }
                    store8(rowp + bj * HALF, v0 * QSCALE, v1 * QSCALE); } }
        return false;
    }
};
struct EpiKV {
    static constexpr bool PERM = true;
    bf16_t* k; bf16_t* v;
    __device__ __forceinline__ bool operator()(Acc& acc, const Unit& u, int wr, int wc, int fr, int fq) const {
        const int row0 = u.pm * BM + wr * 64 + fr, col0 = u.pn * BM + wc * 32 + 8 * fq;
#pragma unroll
        for (int ai = 0; ai < 2; ++ai)
#pragma unroll
            for (int m = 0; m < 4; ++m) { const int row = row0 + ai * HALF + m * 16;
#pragma unroll
                for (int bj = 0; bj < 2; ++bj) { const int c = col0 + bj * HALF, head = c >> 7, d = c & 127;
                    bf16_t* p = d < 64 ? k + (size_t)row * QLD + head * 96 + d : v + (size_t)row * VLD + head * 64 + (d - 64);
                    store8(p, acc[ai][bj][m][0], acc[ai][bj][m][1]); } }
        return false;
    }
};
struct EpiPlain {
    static constexpr bool PERM = true;
    bf16_t* o; int ld;
    __device__ __forceinline__ bool operator()(Acc& acc, const Unit& u, int wr, int wc, int fr, int fq) const {
        const int row0 = u.pm * BM + wr * 64 + fr, col0 = u.pn * BM + wc * 32 + 8 * fq;
#pragma unroll
        for (int ai = 0; ai < 2; ++ai)
#pragma unroll
            for (int m = 0; m < 4; ++m) { bf16_t* rowp = o + (size_t)(row0 + ai * HALF + m * 16) * ld + col0;
#pragma unroll
                for (int bj = 0; bj < 2; ++bj) store8(rowp + bj * HALF, acc[ai][bj][m][0], acc[ai][bj][m][1]); }
        return false;
    }
};
struct EpiMerge {
    static constexpr bool PERM = true;
    const bf16_t* g; bf16_t* o;
    __device__ __forceinline__ bool operator()(Acc& acc, const Unit& u, int wr, int wc, int fr, int fq) const {
        const int row0 = u.pm * BM + wr * 64 + fr, col0 = u.pn * BM + wc * 32 + 8 * fq;
        const bool fin = u.br == 2;
#pragma unroll
        for (int ai = 0; ai < 2; ++ai)
#pragma unroll
            for (int m = 0; m < 4; ++m) { const size_t row = (size_t)(row0 + ai * HALF + m * 16);
#pragma unroll
                for (int bj = 0; bj < 2; ++bj) {
                    const u32x4 ga = *(const u32x4*)(g + row * GLD + u.br * 1024 + col0 + bj * HALF);
                    float f[8] = {bf_lo(ga.x), bf_hi(ga.x), bf_lo(ga.y), bf_hi(ga.y), bf_lo(ga.z), bf_hi(ga.z), bf_lo(ga.w), bf_hi(ga.w)};
                    if (!fin) { const u32x4 gb = *(const u32x4*)(g + row * GLD + (u.br + 1) * 1024 + col0 + bj * HALF);
                        const float h[8] = {bf_lo(gb.x), bf_hi(gb.x), bf_lo(gb.y), bf_hi(gb.y), bf_lo(gb.z), bf_hi(gb.z), bf_lo(gb.w), bf_hi(gb.w)};
#pragma unroll
                        for (int e = 0; e < 8; ++e) f[e] *= __builtin_amdgcn_rcpf(h[e]); }
                    f32x4 v0 = acc[ai][bj][m][0], v1 = acc[ai][bj][m][1];
#pragma unroll
                    for (int e = 0; e < 4; ++e) { v0[e] *= f[e]; v1[e] *= f[4 + e]; }
                    if (fin) store8(o + row * DM + col0 + bj * HALF, v0, v1);
                    else { acc[ai][bj][m][0] = v0; acc[ai][bj][m][1] = v1; } } }
        return !fin;
    }
};
struct EpiZ {
    static constexpr bool PERM = false;
    float* z;
    __device__ __forceinline__ bool operator()(Acc& acc, const Unit& u, int wr, int wc, int fr, int fq) const {
        const int row0 = u.pm * BM + wr * 64 + fr, col0 = u.pn * BM + wc * 32 + 4 * fq;
#pragma unroll
        for (int ai = 0; ai < 2; ++ai)
#pragma unroll
            for (int m = 0; m < 4; ++m) { float* rowp = z + (size_t)(row0 + ai * HALF + m * 16) * DM + col0;
#pragma unroll
                for (int bj = 0; bj < 2; ++bj)
#pragma unroll
                    for (int n = 0; n < 2; ++n) *(f32x4*)(rowp + bj * HALF + n * 16) = acc[ai][bj][m][n]; }
        return false;
    }
};
}

namespace att {
constexpr int NW = 8, QBLK = 32, QB = 256, KVBLK = 64;
constexpr int KSLOT = 12288, VSLOT = 8192;
constexpr int LDS_K = 0, LDS_V = 2 * KSLOT, LDS_WS = LDS_V + 2 * VSLOT, LDS_OST = LDS_WS + NW * 256, LDS_BYTES = LDS_OST + NW * 4096;
__device__ __forceinline__ int crow(int r, int hi) { return (r & 3) + 8 * (r >> 2) + 4 * hi; }
__device__ __forceinline__ void glds16(const void* gsrc, unsigned lds_dst) { unsigned keep;
    asm volatile("s_mov_b32 %0, m0\n\ts_mov_b32 m0, %2\n\ts_nop 0\n\tglobal_load_lds_dwordx4 %1, off\n\ts_mov_b32 m0, %0" : "=&s"(keep) : "v"(gsrc), "s"(lds_dst) : "memory"); }
#define ATT_WAIT_BAR(N) asm volatile("s_waitcnt vmcnt(" #N ") lgkmcnt(0)\n\ts_barrier" ::: "memory")
typedef LAS const char* lds_cptr;
typedef short v4i16_t __attribute__((ext_vector_type(4)));
__device__ __forceinline__ s16x4 vtr(lds_cptr p) { return __builtin_bit_cast(s16x4, __builtin_amdgcn_ds_read_tr16_b64_v4i16((LAS v4i16_t*)p)); }
__device__ __forceinline__ float rowmax32(const f32x16& p0, const f32x16& p1) {
    float a = fmaxf(p0[0], p1[0]);
#pragma unroll
    for (int r = 1; r < 16; ++r) a = fmaxf(a, fmaxf(p0[r], p1[r]));
    auto rr = __builtin_amdgcn_permlane32_swap(__float_as_uint(a), __float_as_uint(a), false, false);
    return fmaxf(__uint_as_float(rr[0]), __uint_as_float(rr[1]));
}

__device__ __forceinline__ void attn_unit(int b, int h, int qb, const bf16_t* Q, const bf16_t* K, const bf16_t* V, bf16_t* Y, LAS char* shm, unsigned lds0) {
    int tid = threadIdx.x; asm volatile("" : "+v"(tid));
    const int lane = tid & 63, r32 = lane & 31, hi = lane >> 5; const int wid = __builtin_amdgcn_readfirstlane(tid >> 6);
    const long rowbase = (long)b * SEQ; const int q0 = qb * QB;
    const bf16_t* Qw = Q + (rowbase + q0 + wid * QBLK) * QLD + h * 96;
    const bf16_t* Kh = K + rowbase * QLD + h * 96; const bf16_t* Vh = V + rowbase * VLD + h * 64;
    LAS float* wsf = (LAS float*)(shm + LDS_WS) + wid * 64;
    const int c2 = 8 + (wid & 3);
    const bf16_t* ksrc0 = Kh + (long)lane * QLD + wid * 8; const bf16_t* ksrc1 = Kh + (long)lane * QLD + c2 * 8;
    const bf16_t* vsrc = Vh + (long)(16 * (wid & 3) + (lane >> 2)) * VLD + (wid >> 2) * 32 + (lane & 3) * 8;
    const unsigned kdst0 = lds0 + LDS_K + wid * 1024, kdst1 = lds0 + LDS_K + c2 * 1024, vdst = lds0 + LDS_V + wid * 1024;
#define ATT_DMA(t, s) do { glds16(ksrc0 + (long)(t) * KVBLK * QLD, (unsigned)__builtin_amdgcn_readfirstlane(kdst0 + (s) * KSLOT)); \
                           glds16(ksrc1 + (long)(t) * KVBLK * QLD, (unsigned)__builtin_amdgcn_readfirstlane(kdst1 + (s) * KSLOT)); \
                           glds16(vsrc + (long)(t) * KVBLK * VLD, (unsigned)__builtin_amdgcn_readfirstlane(vdst + (s) * VSLOT)); } while (0)
    const int NT = (q0 + QB) / KVBLK;
    ATT_DMA(0, 0);
    bf16x8 qr[6];
#pragma unroll
    for (int d0 = 0; d0 < 6; ++d0) qr[d0] = *(const bf16x8*)(Qw + (long)r32 * QLD + d0 * 16 + hi * 8);
    float mrow = -1e30f, l_reg = 0.f; f32x16 o[2]; o[0] = f32x16{}; o[1] = f32x16{};
    const int qrel = wid * QBLK + r32;
    const lds_cptr kp0 = (lds_cptr)shm + LDS_K + hi * 1024 + r32 * 16;
    const lds_cptr vp0 = (lds_cptr)shm + LDS_V + ((lane >> 4) & 1) * 32 + (lane & 3) * 8 + (4 * hi + ((lane & 15) >> 2)) * 64;
    for (int t = 0; t < NT; ++t) {
        ATT_WAIT_BAR(0);
        if (t + 1 < NT) ATT_DMA(t + 1, (t + 1) & 1);
        const lds_cptr kp = kp0 + (t & 1) * KSLOT; const lds_cptr vp = vp0 + (t & 1) * VSLOT;
        f32x16 p0 = f32x16{}, p1 = f32x16{};
#pragma unroll
        for (int d0 = 0; d0 < 6; ++d0) {
            const bf16x8 k0 = *(const LAS bf16x8*)(kp + d0 * 2048), k1 = *(const LAS bf16x8*)(kp + d0 * 2048 + 512);
            p0 = __builtin_amdgcn_mfma_f32_32x32x16_bf16(k0, qr[d0], p0, 0, 0, 0);
            p1 = __builtin_amdgcn_mfma_f32_32x32x16_bf16(k1, qr[d0], p1, 0, 0, 0);
        }
        const int jb = t - (NT - 4);
        if (jb >= 0) { const int kb = 64 * jb + 4 * hi;
#pragma unroll
            for (int r = 0; r < 16; ++r) { const int kv = kb + (r & 3) + 8 * (r >> 2); if (kv > qrel) p0[r] = -INFINITY; if (kv + 32 > qrel) p1[r] = -INFINITY; } }
        const float rm = rowmax32(p0, p1);
        const float mn = fmaxf(mrow, rm), alpha = __builtin_amdgcn_exp2f(mrow - mn);
        mrow = mn;
        float ls = 0.f;
#pragma unroll
        for (int r = 0; r < 16; ++r) { p0[r] = __builtin_amdgcn_exp2f(p0[r] - mn); p1[r] = __builtin_amdgcn_exp2f(p1[r] - mn); ls += p0[r] + p1[r]; }
        l_reg = l_reg * alpha + ls;
        if (__any(alpha != 1.f)) {
            if (hi == 0) wsf[r32] = alpha;
            LDS_WAIT();
#pragma unroll
            for (int r = 0; r < 16; ++r) { const float f = wsf[crow(r, hi)]; o[0][r] *= f; o[1][r] *= f; }
            LDS_WAIT();
        }
        u32x4 pw[4];
        pw[0] = (u32x4){cvtpk(p0[0], p0[1]), cvtpk(p0[2], p0[3]), cvtpk(p0[4], p0[5]), cvtpk(p0[6], p0[7])};
        pw[1] = (u32x4){cvtpk(p0[8], p0[9]), cvtpk(p0[10], p0[11]), cvtpk(p0[12], p0[13]), cvtpk(p0[14], p0[15])};
        pw[2] = (u32x4){cvtpk(p1[0], p1[1]), cvtpk(p1[2], p1[3]), cvtpk(p1[4], p1[5]), cvtpk(p1[6], p1[7])};
        pw[3] = (u32x4){cvtpk(p1[8], p1[9]), cvtpk(p1[10], p1[11]), cvtpk(p1[12], p1[13]), cvtpk(p1[14], p1[15])};
#pragma unroll
        for (int d0 = 0; d0 < 2; ++d0)
#pragma unroll
            for (int ks = 0; ks < 4; ++ks) {
                const s16x4 lo = vtr(vp + d0 * 4096 + ks * 1024), hh = vtr(vp + d0 * 4096 + ks * 1024 + 512);
                const bf16x8 vf = (bf16x8){lo[0], lo[1], lo[2], lo[3], hh[0], hh[1], hh[2], hh[3]};
                o[d0] = __builtin_amdgcn_mfma_f32_32x32x16_bf16(__builtin_bit_cast(bf16x8, pw[ks]), vf, o[d0], 0, 0, 0);
            }
    }
    { auto rr = __builtin_amdgcn_permlane32_swap(__float_as_uint(l_reg), __float_as_uint(l_reg), false, false); l_reg = __uint_as_float(rr[0]) + __uint_as_float(rr[1]); }
    if (hi == 0) wsf[32 + r32] = l_reg; LDS_WAIT();
    float rli[16];
#pragma unroll
    for (int r = 0; r < 16; ++r) rli[r] = __builtin_amdgcn_rcpf(wsf[32 + crow(r, hi)]);
    bf16_t* Yw = Y + (rowbase + q0 + wid * QBLK) * YLD + 512 + h * 64;
    { LAS bf16_t* stg = (LAS bf16_t*)(shm + LDS_OST) + wid * 2048;
#pragma unroll
      for (int r = 0; r < 16; ++r) { const int orow = crow(r, hi);
#pragma unroll
          for (int d0 = 0; d0 < 2; ++d0) stg[orow * 64 + d0 * 32 + r32] = f2bf(o[d0][r] * rli[r]); }
      LDS_WAIT();
#pragma unroll
      for (int i = 0; i < 4; ++i) { const int row = i * 8 + (lane >> 3), ch = lane & 7; const u32x4 v = *(const LAS u32x4*)(stg + row * 64 + ch * 8);
          bf16_t* gp = Yw + (long)row * YLD + ch * 8; const u32x4 gt = *(const u32x4*)gp; u32x4 w;
          w.x = cvtpk(bf_lo(v.x) * bf_lo(gt.x), bf_hi(v.x) * bf_hi(gt.x)); w.y = cvtpk(bf_lo(v.y) * bf_lo(gt.y), bf_hi(v.y) * bf_hi(gt.y));
          w.z = cvtpk(bf_lo(v.z) * bf_lo(gt.z), bf_hi(v.z) * bf_hi(gt.z)); w.w = cvtpk(bf_lo(v.w) * bf_lo(gt.w), bf_hi(v.w) * bf_hi(gt.w));
          *(u32x4*)gp = w; }
      LDS_WAIT(); }
#undef ATT_DMA
}
}

#define XB_TMO      128
#define XB_XCNT(j)  (256  + 64 * (j))
#define XB_XSUB(j)  (1280 + 64 * (j))
#define XB_XGEN(j)  (2304 + 64 * (j))
#define XB_TOP      3328
#define XB_TOPGEN   3392
#define XCD_BAR_WORDS 3456
#define XB_SPIN_CAP (1u << 18)
__device__ __forceinline__ unsigned xb_ld(unsigned* p)              { return __hip_atomic_load(p, __ATOMIC_RELAXED, __HIP_MEMORY_SCOPE_AGENT); }
__device__ __forceinline__ unsigned xb_add(unsigned* p, unsigned v) { return __hip_atomic_fetch_add(p, v, __ATOMIC_RELAXED, __HIP_MEMORY_SCOPE_AGENT); }
__device__ __forceinline__ unsigned xb_xcc_id() { return (unsigned)__builtin_amdgcn_s_getreg((3 << 11) | 20) & 0xFu; }
#define XB_SPIN(cond, bar) do { unsigned _sp = 0; while (cond) { __builtin_amdgcn_s_sleep(1); \
    if ((++_sp & 255u) == 0u) { if (xb_ld(&(bar)[XB_TMO])) break; if (_sp > XB_SPIN_CAP) { atomicAdd(&(bar)[XB_TMO], 1u); break; } } } } while (0)
struct XcdBarrier { unsigned* bar; unsigned x; volatile LAS unsigned* st; };
__device__ __forceinline__ XcdBarrier xcd_barrier_post(unsigned* bar, volatile LAS unsigned* st) {
    XcdBarrier b; b.bar = bar; b.x = xb_xcc_id(); b.st = st;
    if (threadIdx.x == 0) (void)xb_add(&bar[XB_XCNT(b.x)], 1u);
    return b;
}
__device__ __forceinline__ void xcd_barrier_complete(unsigned* bar, unsigned x, unsigned& nloc, unsigned& nx) {
    const unsigned G = gridDim.x * gridDim.y * gridDim.z;
    unsigned sum, cnt, mine, sp = 0u;
    for (;;) {
        sum = 0u; cnt = 0u; mine = 0u;
#pragma unroll
        for (unsigned j = 0; j < 16; ++j) { const unsigned c = xb_ld(&bar[XB_XCNT(j)]); sum += c; cnt += (c > 0u) ? 1u : 0u; mine = (j == x) ? c : mine; }
        if (sum == G) break;
        __builtin_amdgcn_s_sleep(1);
        if ((++sp & 255u) == 0u) { if (xb_ld(&bar[XB_TMO])) break; if (sp > XB_SPIN_CAP) { atomicAdd(&bar[XB_TMO], 1u); break; } }
    }
    nloc = mine > 0u ? mine : 1u; nx = cnt > 0u ? cnt : 1u;
}
__device__ __forceinline__ void xcd_barrier(const XcdBarrier& b) {
    asm volatile("s_waitcnt vmcnt(0)" ::: "memory");
    __syncthreads();
    if (threadIdx.x == 0) {
        unsigned* bar = b.bar;
        __builtin_amdgcn_s_waitcnt(0);
        unsigned nloc = b.st[0], nx = b.st[1];
        if (nloc == 0u) { xcd_barrier_complete(bar, b.x, nloc, nx); b.st[0] = nloc; b.st[1] = nx; }
        const unsigned old = xb_add(&bar[XB_XSUB(b.x)], 1u);
        const unsigned gen = old / nloc;
        if (old + 1u == (gen + 1u) * nloc) {
            __builtin_amdgcn_fence(__ATOMIC_RELEASE, "agent");
            asm volatile("s_waitcnt vmcnt(0)" ::: "memory");
            const unsigned og = xb_add(&bar[XB_TOP], 1u);
            const unsigned tg = og / nx;
            if (og + 1u == (tg + 1u) * nx) xb_add(&bar[XB_TOPGEN], 1u);
            else XB_SPIN(xb_ld(&bar[XB_TOPGEN]) == tg, bar);
            __builtin_amdgcn_fence(__ATOMIC_ACQUIRE, "agent");
            xb_add(&bar[XB_XGEN(b.x)], 1u);
            asm volatile("s_waitcnt vmcnt(0)" ::: "memory");
        } else {
            XB_SPIN(xb_ld(&bar[XB_XGEN(b.x)]) == gen, bar);
            __builtin_amdgcn_fence(__ATOMIC_ACQUIRE, "agent");
            asm volatile("s_waitcnt vmcnt(0)" ::: "memory");
        }
    }
    __syncthreads();
}

constexpr int NWAVES = 8;
constexpr int RING_BYTES = 131072, LDSCTL_OFF = RING_BYTES, MISC_OFF = LDSCTL_OFF + 320, LDS_BYTES = 147456;
static_assert(att::LDS_BYTES <= RING_BYTES, "attention scratch fits the ring region");

template <class F> __device__ __forceinline__ void transpose_item(const float* W, int ldw, bf16_t* WT, int ldwt, LAS float* scr, int k0, int n0, int lane, F scol) {
    const int sc = scol(n0 + (lane & 31));
#pragma unroll 8
    for (int i = 0; i < 32; ++i) { const int kk = 2 * i + (lane >> 5); scr[kk * 33 + (lane & 31)] = sc >= 0 ? W[(size_t)(k0 + kk) * ldw + sc] : 0.f; }
    LDS_WAIT(); asm volatile("" ::: "memory");
    const int c = lane & 7;
#pragma unroll
    for (int j = 0; j < 4; ++j) { const int n = (lane >> 3) + 8 * j; const LAS float* s = scr + (8 * c) * 33 + n;
        u32x4 o; o.x = cvtpk(s[0 * 33], s[1 * 33]); o.y = cvtpk(s[2 * 33], s[3 * 33]); o.z = cvtpk(s[4 * 33], s[5 * 33]); o.w = cvtpk(s[6 * 33], s[7 * 33]);
        *(u32x4*)(WT + (size_t)(n0 + n) * ldwt + k0 + 8 * c) = o; }
    LDS_WAIT(); asm volatile("" ::: "memory");
}
__device__ __forceinline__ int win_scol(int n) {
    if (n < 512) return n;
    if (n < 768) return 1024 + (n - 512);
    if (n < 896) return 1280 + (n - 768);
    if (n < 928) return 1408 + (n - 896);
    if (n < 1024) return -1;
    if (n < 1536) return 1952 + (n - 1024);
    if (n < 2048) return 2464 + (n - 1536);
    if (n < 2560) return 512 + (n - 2048);
    if (n < 3072) return 1440 + (n - 2560);
    if (n < 3584) return 2976 + (n - 3072);
    return 3488 + (n - 3584);
}
__device__ __forceinline__ int wuq_scol(int n) { const int h = n / 96, d = n - h * 96; return h * 96 + (d < 64 ? d : 64 + ((d - 64) >> 1) + 16 * ((d - 64) & 1)); }

__device__ __forceinline__ void rms_row_to_bf16(const float* xrow, const float* g, bf16_t* orow, int lane) {
    const f32x4* xr = (const f32x4*)xrow + lane; f32x4 v[4]; float s = 0.f;
#pragma unroll
    for (int j = 0; j < 4; ++j) { v[j] = xr[64 * j]; s += (v[j].x * v[j].x + v[j].y * v[j].y) + (v[j].z * v[j].z + v[j].w * v[j].w); }
    const float rstd = 1.f / sqrtf(wave_sum(s) * (1.f / DM) + EPS);
    u32x2* o8 = (u32x2*)orow + lane;
#pragma unroll
    for (int j = 0; j < 4; ++j) { const f32x4 gg = ((const f32x4*)g)[lane + 64 * j]; u32x2 w; w.x = cvtpk(v[j].x * rstd * gg.x, v[j].y * rstd * gg.y); w.y = cvtpk(v[j].z * rstd * gg.z, v[j].w * rstd * gg.w); o8[64 * j] = w; }
}

struct Args { const void* in[20]; float* out; unsigned char* ws; int ph_lo, ph_hi, li, pad; };
constexpr int N_PHASES = 1 + 8 * DEPTH;

__global__ void __launch_bounds__(NWAVES * 64, 2) hybrid_fwd(Args args) {
    extern __shared__ __attribute__((aligned(16))) unsigned char lds_raw[];
    LAS unsigned char* lds = (LAS unsigned char*)lds_raw;
    volatile LAS unsigned* MISC = (volatile LAS unsigned*)(lds + MISC_OFF);
    const int G = gridDim.x, bx = blockIdx.x, vcu = (G % 8 == 0) ? (bx % 8) * (G / 8) + bx / 8 : bx;
#define LOAD_TID int tid = threadIdx.x; asm volatile("" : "+v"(tid)); const int lane = tid & 63, wave = __builtin_amdgcn_readfirstlane(tid >> 6); const int gw = vcu * NWAVES + wave, NGW = G * NWAVES; (void)lane; (void)gw; (void)NGW
    typedef __attribute__((address_space(4))) const Args* KArgs;
#define LOAD_PTRS \
    KArgs ap = (KArgs)__builtin_amdgcn_kernarg_segment_ptr(); asm volatile("" : "+s"(ap)); \
    unsigned char* ws = ap->ws; float* out = ap->out; \
    const float* x_in = (const float*)ap->in[0]; const int* positions = (const int*)ap->in[1]; \
    const float* norm_pre = (const float*)ap->in[2]; const float* norm_post = (const float*)ap->in[3]; \
    const float* w_in = (const float*)ap->in[4]; const float* b_gate = (const float*)ap->in[5]; \
    const float* pool_w = (const float*)ap->in[6]; const float* pool_scale = (const float*)ap->in[7]; \
    const float* q_norm = (const float*)ap->in[8]; const float* w_uq = (const float*)ap->in[9]; \
    const float* kv_norm = (const float*)ap->in[10]; const float* w_ukv = (const float*)ap->in[11]; \
    const float* v_norm_g = (const float*)ap->in[12]; const float* v_norm_b = (const float*)ap->in[13]; \
    const float* w_s = (const float*)ap->in[14]; const float* b_s = (const float*)ap->in[15]; \
    const float* w_oa = (const float*)ap->in[16]; const float* w_ob = (const float*)ap->in[17]; const float* w_oc = (const float*)ap->in[18]; \
    const float* w_out = (const float*)ap->in[19]; \
    float* CS = (float*)(ws + WS_CS); \
    bf16_t* Hb = (bf16_t*)(ws + WS_H); bf16_t* PROJ = (bf16_t*)(ws + WS_PROJ); bf16_t* GATES = (bf16_t*)(ws + WS_PROJ); float* Z = (float*)(ws + WS_PROJ); \
    bf16_t* Qb = (bf16_t*)(ws + WS_Q); bf16_t* Kb = (bf16_t*)(ws + WS_K); bf16_t* Vb = (bf16_t*)(ws + WS_V); bf16_t* Yb = (bf16_t*)(ws + WS_Y); \
    unsigned char* wl = ws + WS_W + (size_t)l * W_LAYER; const bf16_t* Win_t = (const bf16_t*)(wl + W_IN); const float* x_prev = l == 0 ? x_in : out; \
    (void)positions; (void)norm_pre; (void)norm_post; (void)w_in; (void)b_gate; (void)pool_w; (void)pool_scale; (void)q_norm; (void)w_uq; (void)kv_norm; (void)w_ukv; (void)v_norm_g; (void)v_norm_b; \
    (void)w_s; (void)b_s; (void)w_oa; (void)w_ob; (void)w_oc; (void)w_out; (void)CS; (void)Hb; (void)PROJ; (void)GATES; (void)Z; (void)Qb; (void)Kb; (void)Vb; (void)Yb; (void)Win_t; (void)x_prev; (void)x_in; (void)out
    unsigned* ctl = (unsigned*)(args.ws + WS_CTL);
    for (int u = threadIdx.x; u < (LDS_BYTES - LDSCTL_OFF) / 4; u += NWAVES * 64) ((LAS unsigned*)(lds + LDSCTL_OFF))[u] = 0u;
    __syncthreads();
    XcdBarrier bar; bar.bar = ctl + CW_BAR; bar.x = 0; bar.st = nullptr;
#if MK_SINGLE
    bar = xcd_barrier_post(ctl + CW_BAR, MISC + 8);
#define GRID_BAR() xcd_barrier(bar)
#else
    (void)MISC; (void)bar;
#define GRID_BAR() do { } while (0)
#endif
    const int lo = args.ph_lo, hi = args.ph_hi;
#ifdef ONLYP
#define IN(k) ((((k) - 1) & 7) + 1 == ONLYP && (k) > 0 && lo <= (k) && (k) < hi || (ONLYP == 0 && (k) == 0 && lo == 0))
#else
#define IN(k) (lo <= (k) && (k) < hi)
#endif
#define SEAM(k) do { if (IN(k) && IN((k) + 1)) GRID_BAR(); } while (0)

    if (IN(0)) {
        const int l = 0; LOAD_PTRS; LOAD_TID;
        LAS float* scr = (LAS float*)(lds + wave * 16384);
        constexpr int I_IN = 16 * (NIN / 32), I_UQ = 4 * 24, I_UKV = 2 * 32, I_POOL = 4 * 2 * 4, I_O = 8 * 32, I_OUT = 16 * 32;
        constexpr int I_LAYER = I_IN + I_UQ + I_UKV + I_POOL + 3 * I_O + I_OUT;
        for (int it = gw; it < DEPTH * I_LAYER; it += NGW) {
            const int l = it / I_LAYER; int r = it - l * I_LAYER;
            unsigned char* wl = ws + WS_W + (size_t)l * W_LAYER;
            if (r < I_IN) { const int nb = r % (NIN / 32), kb = r / (NIN / 32);
                transpose_item(w_in + (size_t)l * DM * 6560, 6560, (bf16_t*)(wl + W_IN), 1024, scr, 64 * kb, 32 * nb, lane, [](int n) { return win_scol(n); }); continue; } r -= I_IN;
            if (r < I_UQ) { const int nb = r % 24, kb = r / 24;
                transpose_item(w_uq + (size_t)l * 256 * 768, 768, (bf16_t*)(wl + W_UQ), 256, scr, 64 * kb, 32 * nb, lane, [](int n) { return wuq_scol(n); }); continue; } r -= I_UQ;
            if (r < I_UKV) { const int nb = r % 32, kb = r / 32;
                transpose_item(w_ukv + (size_t)l * 128 * 1024, 1024, (bf16_t*)(wl + W_UKV), 128, scr, 64 * kb, 32 * nb, lane, [](int n) { return n; }); continue; } r -= I_UKV;
            if (r < I_POOL) { const int g = r >> 3, kb = (r >> 2) & 1, nb = r & 3;
                bf16_t* dst = (bf16_t*)(wl + W_POOL) + (size_t)(g >> 1) * 65536 + (size_t)(128 * (g & 1)) * 256 + 128 * (g & 1);
                transpose_item(pool_w + (size_t)l * 65536 + (size_t)g * 16384, 128, dst, 256, scr, 64 * kb, 32 * nb, lane, [](int n) { return n; }); continue; } r -= I_POOL;
            if (r < 3 * I_O) { const int wsel = r / I_O, rr = r % I_O, nb = rr % 32, kb = rr / 32; const float* src = wsel == 0 ? w_oa : wsel == 1 ? w_ob : w_oc;
                transpose_item(src + (size_t)l * 512 * 1024, 1024, (bf16_t*)(wl + W_OA) + (size_t)wsel * 1024 * 512, 512, scr, 64 * kb, 32 * nb, lane, [](int n) { return n; }); continue; } r -= 3 * I_O;
            { const int nb = r % 32, kb = r / 32;
                transpose_item(w_out + (size_t)l * 1024 * 1024, 1024, (bf16_t*)(wl + W_OUT), 1024, scr, 64 * kb, 32 * nb, lane, [](int n) { return n; }); }
        }
        const int gt = vcu * 512 + tid, NGT = G * 512;
        for (int i = gt; i < DEPTH * 2 * 2 * 16384; i += NGT) { const int l = i / 65536, r = i % 65536, pr = r / 32768, ob = (r / 16384) & 1, e = r % 16384, rr = e / 128, cc = e % 128;
            bf16_t* dst = (bf16_t*)(ws + WS_W + (size_t)l * W_LAYER + W_POOL) + (size_t)pr * 65536; dst[(size_t)(128 * ob + rr) * 256 + 128 * (1 - ob) + cc] = 0; }
        for (int i = gt; i < DEPTH * 8 * 16384; i += NGT) { const int l = i / 131072, r = i % 131072, e = r % 16384, t = e / 128, s = e % 128;
            ((bf16_t*)(ws + WS_W + (size_t)l * W_LAYER + W_S))[r] = f2bf(s <= t ? w_s[i] : 0.f); }
        for (int i = gt; i < M * 16; i += NGT) { const int row = i >> 4, j = i & 15; const float inv = powf(10000.f, -(float)(2 * j) / 32.f); const float ang = (float)positions[row] * inv;
            float sn, cn; sincosf(ang, &sn, &cn); CS[(size_t)row * 32 + 2 * j] = cn; CS[(size_t)row * 32 + 2 * j + 1] = sn; }
        for (int m = gw; m < M; m += NGW) rms_row_to_bf16(x_in + (size_t)m * DM, norm_pre, Hb + (size_t)m * DM, lane);
    }
    SEAM(0);

#pragma unroll 1
    for (int l = 0; l < DEPTH; ++l) {
        const int pb = 1 + 8 * l;

        if (IN(pb + 0)) {
            LOAD_PTRS; LOAD_TID;
            pg8::Prob P{}; P.A = Hb; P.Bt = Win_t; P.lda = DM; P.ldb = DM; P.K = DM; P.T.init(M, NPROJ, G, bx); P.nbr = 1;
            pg8::EpiProj E{PROJ, Yb};
            pg8::gemm_phase<pg8::EpiProj, true, true>(lds, P, E);
        }
        SEAM(pb + 0);

        if (IN(pb + 1)) {
            LOAD_PTRS; LOAD_TID;
            const float* qn = q_norm + l * 256; const float* kn = kv_norm + l * 128; const float* vg = v_norm_g + l * 512; const float* vb = v_norm_b + l * 512;
            for (int m = gw; m < M; m += NGW) {
                bf16_t* pr = PROJ + (size_t)m * PLD;
                { u32x2* p = (u32x2*)(pr + 512) + lane; const u32x2 w = *p; float a = bf_lo(w.x), b = bf_hi(w.x), c = bf_lo(w.y), d = bf_hi(w.y);
                  const float rstd = 1.f / sqrtf(wave_sum(a * a + b * b + c * c + d * d) * (1.f / 256.f) + EPS); const f32x4 g = ((const f32x4*)qn)[lane];
                  u32x2 o; o.x = cvtpk(a * rstd * g.x, b * rstd * g.y); o.y = cvtpk(c * rstd * g.z, d * rstd * g.w); *p = o; }
                { unsigned* p = (unsigned*)(pr + 768) + lane; const unsigned w = *p; float a = bf_lo(w), b = bf_hi(w);
                  const float rstd = 1.f / sqrtf(wave_sum(a * a + b * b) * (1.f / 128.f) + EPS); const f32x2 g = ((const f32x2*)kn)[lane];
                  *p = cvtpk(a * rstd * g.x, b * rstd * g.y); }
                if (lane < 16) { const float x1 = bf2f(pr[896 + lane]), x2 = bf2f(pr[912 + lane]); const f32x2 cs = ((const f32x2*)(CS + (size_t)m * 32))[lane];
                  const unsigned w = cvtpk(x1 * cs.x - x2 * cs.y, x2 * cs.x + x1 * cs.y);
#pragma unroll
                  for (int h = 0; h < 8; ++h) ((unsigned*)(Kb + (size_t)m * QLD + h * 96 + 64))[lane] = w; }
                { u32x4* p = (u32x4*)(pr + 1536) + lane; const u32x4 w = *p; float f[8] = {bf_lo(w.x), bf_hi(w.x), bf_lo(w.y), bf_hi(w.y), bf_lo(w.z), bf_hi(w.z), bf_lo(w.w), bf_hi(w.w)};
                  float s = 0.f;
#pragma unroll
                  for (int e = 0; e < 8; ++e) s += f[e];
                  const float mean = wave_sum(s) * (1.f / 512.f); float s2 = 0.f;
#pragma unroll
                  for (int e = 0; e < 8; ++e) { f[e] -= mean; s2 += f[e] * f[e]; }
                  const float rstd = 1.f / sqrtf(wave_sum(s2) * (1.f / 512.f) + EPS);
                  const f32x4 g0 = ((const f32x4*)vg)[2 * lane], g1 = ((const f32x4*)vg)[2 * lane + 1], b0 = ((const f32x4*)vb)[2 * lane], b1 = ((const f32x4*)vb)[2 * lane + 1];
                  u32x4 o; o.x = cvtpk(f[0] * rstd * g0.x + b0.x, f[1] * rstd * g0.y + b0.y); o.y = cvtpk(f[2] * rstd * g0.z + b0.z, f[3] * rstd * g0.w + b0.w);
                  o.z = cvtpk(f[4] * rstd * g1.x + b1.x, f[5] * rstd * g1.y + b1.y); o.w = cvtpk(f[6] * rstd * g1.z + b1.z, f[7] * rstd * g1.w + b1.w); *p = o; }
            }
        }
        SEAM(pb + 1);

        if (IN(pb + 2)) {
            LOAD_PTRS; LOAD_TID;
#ifndef P2BM
#define P2BM 15
#endif
            if (P2BM & 1) { pg8::Prob P{}; P.A = PROJ; P.Bt = (const bf16_t*)(wl + W_UQ); P.lda = PLD; P.ldb = 256; P.K = 256; P.T.init(M, 768, G, bx); P.a_col0 = 512; P.nbr = 1;
              pg8::EpiQ E{Qb, CS}; pg8::gemm_phase<pg8::EpiQ, true, true>(lds, P, E); }
            if (P2BM & 2) { pg8::Prob P{}; P.A = PROJ; P.Bt = (const bf16_t*)(wl + W_UKV); P.lda = PLD; P.ldb = 128; P.K = 128; P.T.init(M, 1024, G, bx); P.a_col0 = 768; P.nbr = 1;
              pg8::EpiKV E{Kb, Vb}; pg8::gemm_phase<pg8::EpiKV, true, true>(lds, P, E); }
            if (P2BM & 4) { pg8::Prob P{}; P.A = PROJ; P.Bt = (const bf16_t*)(wl + W_POOL); P.lda = PLD; P.ldb = 256; P.K = 256; P.T.init(M, 512, G, (bx + G / 2) % G); P.a_col0 = 0; P.a_col_per_pn = 256; P.nbr = 1;
              pg8::EpiPlain E{PROJ, PLD}; pg8::gemm_phase<pg8::EpiPlain, true, true>(lds, P, E); }
            __syncthreads();
            const bf16_t* Wsb = (const bf16_t*)(wl + W_S);
            if (P2BM & 8) for (int ch = vcu; ch < M / 128; ch += G) {
                const int g = wave; LAS unsigned char* img = lds + g * 16384;
                const bf16_t* vsrc = PROJ + (size_t)(ch * 128) * PLD + 1536 + 64 * g;
#pragma unroll
                for (int hh = 0; hh < 2; ++hh)
#pragma unroll
                    for (int i = 0; i < 8; ++i) { const int row = 16 * i + (lane >> 2);
                        const u32x4 w = *(const u32x4*)(vsrc + (size_t)row * PLD + 32 * hh + (lane & 3) * 8);
                        *(LAS u32x4*)(img + hh * 8192 + row * 64 + (lane & 3) * 16) = w; }
                LDS_WAIT();
                const int r32 = lane & 31, hi = lane >> 5;
                const att::lds_cptr vp = (att::lds_cptr)img + (8 * hi + ((lane & 15) >> 2)) * 64 + ((lane >> 4) & 1) * 32 + (lane & 3) * 8;
                const bf16_t* wg = Wsb + (size_t)g * 16384;
                const float* bs = b_s + (size_t)l * 1024 + g * 128;
#pragma unroll 1
                for (int ti = 0; ti < 4; ++ti) {
                    f32x16 a0 = f32x16{}, a1 = f32x16{};
                    for (int ks = 0; ks <= 2 * ti + 1; ++ks) {
                        const bf16x8 af = *(const bf16x8*)(wg + (size_t)(32 * ti + r32) * 128 + 16 * ks + 8 * hi);
                        const s16x4 l0 = att::vtr(vp + ks * 1024), h0 = att::vtr(vp + ks * 1024 + 256), l1 = att::vtr(vp + 8192 + ks * 1024), h1 = att::vtr(vp + 8192 + ks * 1024 + 256);
                        const bf16x8 b0 = (bf16x8){l0[0], l0[1], l0[2], l0[3], h0[0], h0[1], h0[2], h0[3]}, b1 = (bf16x8){l1[0], l1[1], l1[2], l1[3], h1[0], h1[1], h1[2], h1[3]};
                        a0 = __builtin_amdgcn_mfma_f32_32x32x16_bf16(af, b0, a0, 0, 0, 0);
                        a1 = __builtin_amdgcn_mfma_f32_32x32x16_bf16(af, b1, a1, 0, 0, 0);
                    }
#pragma unroll
                    for (int r = 0; r < 16; ++r) { const int t = 32 * ti + att::crow(r, hi); const size_t row = (size_t)(ch * 128 + t); const float bb = bs[t];
                        const bf16_t* up = PROJ + row * PLD + 1024 + 64 * g + r32; bf16_t* yp = Yb + row * YLD + 1024 + 64 * g + r32;
                        yp[0] = f2bf(bf2f(up[0]) * (a0[r] + bb) * bf2f(yp[0])); yp[32] = f2bf(bf2f(up[32]) * (a1[r] + bb) * bf2f(yp[32])); }
                }
                LDS_WAIT();
            }
        }
        SEAM(pb + 2);

        if (IN(pb + 3)) {
            LOAD_PTRS; LOAD_TID;
            const float* psc = pool_scale + l * 512;
            for (int st = vcu; st < M / 64; st += G) {
                const int cp = tid & 255, sub = tid >> 8, c0 = 2 * cp, w = 2 << (c0 >> 7);
                const int t0 = st * 64 + sub * 32; const float sc0 = psc[c0], sc1 = psc[c0 + 1];
                float s0 = 0.f, s1 = 0.f;
                for (int j = 1; j < w; ++j) { const int t = t0 - j; if ((t0 & (SEQ - 1)) - j >= 0) { const unsigned v = *(const unsigned*)(PROJ + (size_t)t * PLD + c0); s0 += bf_lo(v); s1 += bf_hi(v); } }
                for (int i = 0; i < 32; ++i) { const int t = t0 + i, tau = t & (SEQ - 1);
                    const unsigned v = *(const unsigned*)(PROJ + (size_t)t * PLD + c0); const float p0 = bf_lo(v), p1 = bf_hi(v);
                    s0 += p0; s1 += p1;
                    const float inv = 1.f / (float)(tau + 1 < w ? tau + 1 : w);
                    unsigned* yp = (unsigned*)(Yb + (size_t)t * YLD + c0); const unsigned gt = *yp;
                    *yp = cvtpk((s0 * inv - p0) * sc0 * bf_lo(gt), (s1 * inv - p1) * sc1 * bf_hi(gt));
                    if (tau - (w - 1) >= 0) { const unsigned vo = *(const unsigned*)(PROJ + (size_t)(t - (w - 1)) * PLD + c0); s0 -= bf_lo(vo); s1 -= bf_hi(vo); } }
            }
            __syncthreads();
            const unsigned lds0 = (unsigned)(uintptr_t)lds_raw;
            for (int k = vcu; k < 512; k += G) { const int p = k & 255, bh = p >> 4, s = p & 15; const int qb = k < 256 ? s : 31 - s;
                att::attn_unit(bh >> 3, bh & 7, qb, Qb, Kb, Vb, Yb, (LAS char*)lds, lds0); }
            __syncthreads();
        }
        SEAM(pb + 3);

        if (IN(pb + 4)) {
            LOAD_PTRS; LOAD_TID;
            pg8::Prob P{}; P.A = Hb; P.Bt = Win_t + (size_t)NPROJ * DM; P.lda = DM; P.ldb = DM; P.K = DM; P.T.init(M, NGATE, G, bx); P.nbr = 1;
            pg8::EpiGate E{GATES, b_gate + l * NGATE};
            pg8::gemm_phase<pg8::EpiGate, true, true>(lds, P, E);
        }
        SEAM(pb + 4);

        if (IN(pb + 5)) {
            LOAD_PTRS; LOAD_TID;
            pg8::Prob P{}; P.A = Yb; P.Bt = (const bf16_t*)(wl + W_OA); P.lda = YLD; P.ldb = 512; P.K = 512; P.T.init(M, DM, G, bx); P.nbr = 3; P.a_col_per_br = 512; P.b_per_br = (size_t)1024 * 512;
            pg8::EpiMerge E{GATES, Hb};
            pg8::gemm_phase<pg8::EpiMerge, false, true>(lds, P, E);
        }
        SEAM(pb + 5);

        if (IN(pb + 6)) {
            LOAD_PTRS; LOAD_TID;
            pg8::Prob P{}; P.A = Hb; P.Bt = (const bf16_t*)(wl + W_OUT); P.lda = DM; P.ldb = DM; P.K = DM; P.T.init(M, DM, G, bx); P.nbr = 1;
            pg8::EpiZ E{Z};
            pg8::gemm_phase<pg8::EpiZ, false, true>(lds, P, E);
        }
        SEAM(pb + 6);

        if (IN(pb + 7)) {
            LOAD_PTRS; LOAD_TID;
            const float* gp = norm_post + l * DM; const float* gn = norm_pre + (l + 1 < DEPTH ? l + 1 : l) * DM;
            for (int m = gw; m < M; m += NGW) {
                const f32x4* zr = (const f32x4*)(Z + (size_t)m * DM) + lane; const f32x4* xr = (const f32x4*)(x_prev + (size_t)m * DM) + lane; f32x4* orow = (f32x4*)(out + (size_t)m * DM) + lane;
                f32x4 v[4]; float s = 0.f;
#pragma unroll
                for (int j = 0; j < 4; ++j) { v[j] = zr[64 * j]; s += (v[j].x * v[j].x + v[j].y * v[j].y) + (v[j].z * v[j].z + v[j].w * v[j].w); }
                const float rstd = 1.f / sqrtf(wave_sum(s) * (1.f / DM) + EPS); float s2 = 0.f;
#pragma unroll
                for (int j = 0; j < 4; ++j) { const f32x4 g = ((const f32x4*)gp)[lane + 64 * j]; v[j] = xr[64 * j] + v[j] * rstd * g; orow[64 * j] = v[j];
                    s2 += (v[j].x * v[j].x + v[j].y * v[j].y) + (v[j].z * v[j].z + v[j].w * v[j].w); }
                if (l + 1 < DEPTH) { const float r2 = 1.f / sqrtf(wave_sum(s2) * (1.f / DM) + EPS); u32x2* o8 = (u32x2*)(Hb + (size_t)m * DM) + lane;
#pragma unroll
                    for (int j = 0; j < 4; ++j) { const f32x4 g = ((const f32x4*)gn)[lane + 64 * j]; u32x2 w; w.x = cvtpk(v[j].x * r2 * g.x, v[j].y * r2 * g.y); w.y = cvtpk(v[j].z * r2 * g.z, v[j].w * r2 * g.w); o8[64 * j] = w; } }
            }
        }
        if (l + 1 < DEPTH) SEAM(pb + 7);
    }
#undef IN
#undef SEAM
}

extern "C" void kernel_launch(void* const* d_in, const int* in_sizes, int n_in, void* d_out, int out_size, void* d_ws, size_t ws_size, hipStream_t stream) {
    static int grid = 0;
    if (grid == 0) {
        if (n_in != 20 || out_size != M * DM || ws_size < WS_END) { fprintf(stderr, "kernel_launch: unexpected shapes (n_in %d out %d ws %zu)\n", n_in, out_size, ws_size); grid = -1; return; }
        int dev = 0, cus = 0, per_cu = 0;
        if (hipGetDevice(&dev) != hipSuccess || hipDeviceGetAttribute(&cus, hipDeviceAttributeMultiprocessorCount, dev) != hipSuccess) { grid = -1; return; }
        if (hipFuncSetAttribute((const void*)hybrid_fwd, hipFuncAttributeMaxDynamicSharedMemorySize, LDS_BYTES) != hipSuccess) { fprintf(stderr, "kernel_launch: hipFuncSetAttribute failed\n"); grid = -1; return; }
        if (hipOccupancyMaxActiveBlocksPerMultiprocessor(&per_cu, (const void*)hybrid_fwd, NWAVES * 64, LDS_BYTES) != hipSuccess || per_cu < 1) { fprintf(stderr, "kernel_launch: occupancy query says %d\n", per_cu); per_cu = 1; }
        (void)hipGetLastError();
        grid = cus;
    }
    if (grid < 0) return;
    (void)hipMemsetAsync((char*)d_ws + WS_CTL, 0, CTL_ZERO_BYTES, stream);
    Args a{};
    for (int i = 0; i < 20; ++i) a.in[i] = d_in[i];
    a.out = (float*)d_out; a.ws = (unsigned char*)d_ws;
#if MK_SINGLE
    a.ph_lo = 0; a.ph_hi = N_PHASES; a.li = 0;
    hipLaunchKernelGGL(hybrid_fwd, dim3(grid), dim3(NWAVES * 64), LDS_BYTES, stream, a);
#else
    for (int p = 0; p < N_PHASES; ++p) { a.ph_lo = p; a.ph_hi = p + 1; a.li = p; hipLaunchKernelGGL(hybrid_fwd, dim3(grid), dim3(NWAVES * 64), LDS_BYTES, stream, a); }
#endif
}
```

```cpp
#include <hip/hip_runtime.h>
#include <hip/hip_bf16.h>
#include <cstdio>
#include <cstdint>
#include <cmath>

#ifndef MK_SINGLE
#define MK_SINGLE 1
#endif

#define LAS __attribute__((address_space(3)))
#define GAS __attribute__((address_space(1)))
typedef unsigned short bf16_t;
typedef short bf16x8 __attribute__((ext_vector_type(8)));
typedef short s16x4 __attribute__((ext_vector_type(4)));
typedef float f32x4 __attribute__((ext_vector_type(4)));
typedef float f32x2 __attribute__((ext_vector_type(2)));
typedef float f32x16 __attribute__((ext_vector_type(16)));
typedef unsigned u32x4 __attribute__((ext_vector_type(4)));
typedef unsigned u32x2 __attribute__((ext_vector_type(2)));
typedef __bf16 bf16x2_t __attribute__((ext_vector_type(2)));

constexpr int BATCH = 2, SEQ = 8192, DM = 1024, M = BATCH * SEQ, DEPTH = 2;
constexpr int NPROJ = 3584, NGATE = 3072, NIN = NPROJ + NGATE;
constexpr int PLD = 2048;
constexpr int YLD = 1536;
constexpr int QLD = 768, KLD = 512, VLD = 512, GLD = 3072;
constexpr float EPS = 1e-6f;
constexpr float QSCALE = 0.10206207261596575f * 1.4426950408889634f;

constexpr size_t MiB = 1u << 20;
constexpr size_t WS_CTL = 0, CTL_ZERO_BYTES = 1 * MiB;
constexpr size_t WS_CS = 1 * MiB;
constexpr size_t WS_W = 3 * MiB, W_LAYER = 20 * MiB;
constexpr size_t W_IN = 0, W_UQ = 13 * MiB, W_UKV = 13 * MiB + 512 * 1024, W_POOL = 14 * MiB, W_S = 14 * MiB + 256 * 1024,
                 W_OA = 14 * MiB + 512 * 1024, W_OUT = 17 * MiB + 512 * 1024;
constexpr size_t WS_H = 43 * MiB;
constexpr size_t WS_PROJ = 75 * MiB;
constexpr size_t WS_Q = 139 * MiB, WS_K = 163 * MiB, WS_V = 187 * MiB;
constexpr size_t WS_Y = 203 * MiB;
constexpr size_t WS_SSQ = 251 * MiB;
constexpr size_t WS_KR = 252 * MiB;
constexpr size_t WS_END = 253 * MiB;
constexpr int CW_BAR = 4096;

__device__ __forceinline__ unsigned cvtpk(float lo, float hi) { f32x2 v = {lo, hi}; bf16x2_t b = __builtin_convertvector(v, bf16x2_t); return __builtin_bit_cast(unsigned, b); }
__device__ __forceinline__ float bf_lo(unsigned w) { return __uint_as_float(w << 16); }
__device__ __forceinline__ float bf_hi(unsigned w) { return __uint_as_float(w & 0xffff0000u); }
__device__ __forceinline__ float bf2f(bf16_t h) { return __uint_as_float(((unsigned)h) << 16); }
__device__ __forceinline__ bf16_t f2bf(float f) { return (bf16_t)(cvtpk(f, 0.f) & 0xffffu); }
__device__ __forceinline__ float sigmoid_f(float v) { return __builtin_amdgcn_rcpf(1.f + __builtin_amdgcn_exp2f(-1.4426950408889634f * v)); }
__device__ __forceinline__ float silu_f(float v) { return v * sigmoid_f(v); }
__device__ __forceinline__ float wave_sum(float v) {
#pragma unroll
    for (int o = 1; o < 64; o <<= 1) v += __shfl_xor(v, o);
    return v;
}
#define LDS_WAIT() asm volatile("s_waitcnt lgkmcnt(0)" ::: "memory")
#define VM_WAIT() asm volatile("s_waitcnt vmcnt(0)" ::: "memory")

namespace pg8 {
constexpr int BM = 256, BK = 64, HALF = 128, HTB = HALF * BK * 2, STAGE_BYTES = 8 * HTB, NXCD = 8, WGM = 8;
__host__ __device__ __forceinline__ int lds_byte(int r, int c) { const int st = (r >> 4) * 2 + (c >> 5), rr = r & 15, cc = c & 31, ob = rr * 64 + cc * 2; return st * 1024 + (ob ^ (((ob >> 9) & 1) << 5)); }
__host__ __device__ __forceinline__ void stage_rc(int b, int& R, int& C) { const int st = b / 1024, sb = b % 1024, swz = sb ^ (((sb >> 9) & 1) << 5); R = (st >> 1) * 16 + swz / 64; C = (st & 1) * 32 + (swz % 64) / 2; }
__host__ __device__ __forceinline__ int perm32(int rho) { const int n = rho >> 4, i = rho & 15; return 8 * (i >> 2) + 4 * n + (i & 3); }

struct Unit { int pm, pn, br; };
struct TileOrder {
    int nM, nN, nwg, G, c;
    __device__ __forceinline__ void init(int Mrows, int N, int G_, int c_) { nM = Mrows / BM; nN = N / BM; nwg = nM * nN; G = G_; c = c_; }
    __device__ __forceinline__ bool tile(int i, int& pm, int& pn) const { return tileL((long)i * G + c, pm, pn); }
    __device__ __forceinline__ bool tileL(long L, int& pm, int& pn) const {
        if (L >= nwg) return false;
        int wgid = (int)L; { const int q = nwg / NXCD, r = nwg % NXCD, xcd = wgid % NXCD, off = wgid / NXCD; wgid = (xcd < r ? xcd * (q + 1) : r * (q + 1) + (xcd - r) * q) + off; }
        const int nig = WGM * nN, gid = wgid / nig, fm = gid * WGM, gsz = (nM - fm) < WGM ? (nM - fm) : WGM;
        pm = fm + ((wgid % nig) % gsz); pn = (wgid % nig) / gsz; return true;
    }
};
struct Prob {
    const bf16_t* A; const bf16_t* Bt; int lda, ldb, K; TileOrder T;
    int a_col_per_pn, a_col0;
    int a_col_per_br; size_t b_per_br; int nbr;
    __device__ __forceinline__ bool next(int i, Unit& u) const { const int ti = i / nbr; u.br = i - ti * nbr; return T.tile(ti, u.pm, u.pn); }
    __device__ __forceinline__ const char* aptr(const Unit& u) const { return (const char*)(A + (size_t)u.pm * BM * lda + a_col0 + a_col_per_pn * u.pn + a_col_per_br * u.br); }
    __device__ __forceinline__ const char* bptr(const Unit& u) const { return (const char*)(Bt + (size_t)u.pn * BM * ldb + b_per_br * u.br); }
    __device__ __forceinline__ int nt(const Unit&) const { return K / BK; }
};
struct ProbMix {
    const bf16_t* A; const unsigned char* wl; int lda, ldb, G, c;
    __device__ __forceinline__ static void xcd_tile(int L, int nN, int nwg, int& pm, int& pn) {
        const int q = nwg / NXCD, xcd = L % NXCD, off = L / NXCD, wgid = xcd * q + off;
        const int nig = WGM * nN, gid = wgid / nig; pm = gid * WGM + ((wgid % nig) % WGM); pn = (wgid % nig) / WGM; }
    __device__ __forceinline__ bool next(int i, Unit& u) const { const int L = i * G + c;
        if (L < 256) { u.br = 0; xcd_tile(L, 4, 256, u.pm, u.pn); return true; }
        if (L < 448) { u.br = 1; xcd_tile(L - 256, 3, 192, u.pm, u.pn); return true; }
        if (L < 576) { u.br = 2; u.pm = (L - 448) >> 1; u.pn = (L - 448) & 1; return true; }
        u.br = 0; u.pm = 0; u.pn = 0; return false; }
    __device__ __forceinline__ const char* aptr(const Unit& u) const { return (const char*)(A + (size_t)u.pm * BM * lda + (u.br == 0 ? 768 : u.br == 1 ? 512 : 256 * u.pn)); }
    __device__ __forceinline__ const char* bptr(const Unit& u) const { const size_t off = u.br == 0 ? W_UKV : u.br == 1 ? W_UQ : W_POOL; return (const char*)(wl + off) + (size_t)u.pn * BM * ldb * 2; }
    __device__ __forceinline__ int nt(const Unit& u) const { return u.br == 0 ? 2 : 4; }
};
template <class Epi, bool ALIGN_EPI, bool SP2, class ProbT>
__device__ __forceinline__ void gemm_phase(LAS unsigned char* lds, const ProbT& P, const Epi& E) {
    int tid = threadIdx.x; asm volatile("" : "+v"(tid));
    const int wid = __builtin_amdgcn_readfirstlane(tid >> 6), lane = tid & 63, wr = wid >> 2, wc = wid & 3, fr = lane & 15, fq = lane >> 4;
    unsigned voffA[2], voffB[2];
#pragma unroll
    for (int i = 0; i < 2; ++i) { int R, C; stage_rc(tid * 16 + i * 8192, R, C); const int Rb = Epi::PERM ? ((R & ~31) + perm32(R & 31)) : R;
        voffA[i] = (unsigned)(R * P.lda + C) * 2u; voffB[i] = (unsigned)(Rb * P.ldb + C) * 2u; }
    const size_t kstep = (size_t)(BK * 2);
    const size_t hstepA = (size_t)HALF * P.lda * 2, hstepB = (size_t)HALF * P.ldb * 2;
    const unsigned ldsw = (unsigned)wid * 1024u;
    const int aoff = lds_byte(wr * 64 + fr, fq * 8), boff = lds_byte(wc * 32 + fr, fq * 8);
#define PG8_SA(b, h) (((b) * 2 + (h)) * HTB)
#define PG8_SB(b, h) ((4 + (b) * 2 + (h)) * HTB)
#define PG8_STAGE(bufoff, gbase, voff) do { _Pragma("unroll") for (int _i = 0; _i < 2; ++_i) \
        __builtin_amdgcn_global_load_lds((const unsigned*)((const char*)(gbase) + (voff)[_i]), (LAS unsigned*)(lds + (bufoff) + ldsw + _i * 8192), 16, 0, 0); } while (0)
#define PG8_LDA(dst, b, h) do { _Pragma("unroll") for (int m = 0; m < 4; ++m) _Pragma("unroll") for (int k = 0; k < 2; ++k) dst[m][k] = *(const LAS bf16x8*)(lds + PG8_SA(b, h) + aoff + m * 2048 + k * 1024); } while (0)
#define PG8_LDB(dst, b, h) do { _Pragma("unroll") for (int n = 0; n < 2; ++n) _Pragma("unroll") for (int k = 0; k < 2; ++k) dst[n][k] = *(const LAS bf16x8*)(lds + PG8_SB(b, h) + boff + n * 2048 + k * 1024); } while (0)
#define PG8_MMA(ai, bj, At, Bt) do { __builtin_amdgcn_s_setprio(1); _Pragma("unroll") for (int m = 0; m < 4; ++m) _Pragma("unroll") for (int n = 0; n < 2; ++n) _Pragma("unroll") for (int k = 0; k < 2; ++k) \
        acc[ai][bj][m][n] = __builtin_amdgcn_mfma_f32_16x16x32_bf16(Bt[n][k], At[m][k], acc[ai][bj][m][n], 0, 0, 0); __builtin_amdgcn_s_setprio(0); } while (0)
#define PG8_WAIT_V(n) asm volatile("s_waitcnt vmcnt(" #n ")" ::: "memory")
#define PG8_WAIT_L(n) asm volatile("s_waitcnt lgkmcnt(" #n ")" ::: "memory")
#define PG8_BAR __builtin_amdgcn_s_barrier()
#define PG8_SCHED __builtin_amdgcn_sched_barrier(0)
    Unit cur, nxt; int ui = 0;
    if (!P.next(0, cur)) return;
    int nt = __builtin_amdgcn_readfirstlane(P.nt(cur)); asm volatile("" : "+s"(nt));
    f32x4 acc[2][2][4][2];
#pragma unroll
    for (int a = 0; a < 2; ++a)
#pragma unroll
        for (int b = 0; b < 2; ++b)
#pragma unroll
            for (int m = 0; m < 4; ++m)
#pragma unroll
                for (int n = 0; n < 2; ++n) acc[a][b][m][n] = (f32x4){0.f, 0.f, 0.f, 0.f};
    bf16x8 At[4][2], B0[2][2], B1[2][2];
    const char* cA = P.aptr(cur); const char* cB = P.bptr(cur);
    if constexpr (SP2) {
        PG8_STAGE(PG8_SB(0, 0), cB, voffB); PG8_STAGE(PG8_SB(0, 1), cB + hstepB, voffB); PG8_STAGE(PG8_SA(0, 0), cA, voffA); PG8_STAGE(PG8_SA(0, 1), cA + hstepA, voffA);
        if (wr == 1) PG8_BAR;
        PG8_WAIT_V(2); PG8_BAR;
        PG8_STAGE(PG8_SB(1, 0), cB + kstep, voffB); PG8_STAGE(PG8_SA(1, 0), cA + kstep, voffA); PG8_STAGE(PG8_SB(1, 1), cB + hstepB + kstep, voffB);
        PG8_WAIT_V(6); PG8_BAR;
    } else {
        PG8_STAGE(PG8_SB(0, 0), cB, voffB); PG8_STAGE(PG8_SA(0, 0), cA, voffA); PG8_STAGE(PG8_SB(0, 1), cB + hstepB, voffB); PG8_STAGE(PG8_SA(0, 1), cA + hstepA, voffA);
        if (wr == 1) PG8_BAR;
        PG8_WAIT_V(4); PG8_BAR;
        PG8_STAGE(PG8_SB(1, 0), cB + kstep, voffB); PG8_STAGE(PG8_SA(1, 0), cA + kstep, voffA); PG8_STAGE(PG8_SB(1, 1), cB + hstepB + kstep, voffB);
        PG8_WAIT_V(6); PG8_BAR;
    }
    for (;;) {
        const bool has_next = P.next(ui + 1, nxt);
        const char* nA = has_next ? P.aptr(nxt) : cA; const char* nB = has_next ? P.bptr(nxt) : cB;
        for (int t = 0; t < nt; t += 2) {
            const bool last = (t == nt - 2);
            const char* a1 = cA + (size_t)(t + 1) * kstep;
            const char* a2 = last ? nA : cA + (size_t)(t + 2) * kstep; const char* b2 = last ? nB : cB + (size_t)(t + 2) * kstep;
            const char* a3 = a2 + kstep; const char* b3 = b2 + kstep;
            if constexpr (SP2) {
            PG8_LDB(B0, 0, 0); PG8_LDB(B1, 0, 1); PG8_SCHED; PG8_LDA(At, 0, 0); PG8_STAGE(PG8_SA(1, 1), a1 + hstepA, voffA);
            PG8_WAIT_V(8); PG8_WAIT_L(0); PG8_BAR; PG8_MMA(0, 0, At, B0); PG8_MMA(0, 1, At, B1); PG8_BAR; PG8_SCHED;
            PG8_LDA(At, 0, 1); PG8_STAGE(PG8_SB(0, 0), b2, voffB); PG8_STAGE(PG8_SB(0, 1), b2 + hstepB, voffB); PG8_STAGE(PG8_SA(0, 0), a2, voffA);
            PG8_WAIT_V(8); PG8_WAIT_L(0); PG8_BAR; PG8_MMA(1, 0, At, B0); PG8_MMA(1, 1, At, B1); PG8_BAR; PG8_SCHED;
            PG8_LDB(B0, 1, 0); PG8_LDB(B1, 1, 1); PG8_SCHED; PG8_LDA(At, 1, 0); PG8_STAGE(PG8_SA(0, 1), a2 + hstepA, voffA);
            PG8_WAIT_V(8); PG8_WAIT_L(0); PG8_BAR; PG8_MMA(0, 0, At, B0); PG8_MMA(0, 1, At, B1); PG8_BAR; PG8_SCHED;
            PG8_LDA(At, 1, 1); PG8_STAGE(PG8_SB(1, 0), b3, voffB); PG8_STAGE(PG8_SB(1, 1), b3 + hstepB, voffB); PG8_STAGE(PG8_SA(1, 0), a3, voffA);
            PG8_WAIT_V(8); PG8_WAIT_L(0); PG8_BAR; PG8_MMA(1, 0, At, B0); PG8_MMA(1, 1, At, B1); PG8_BAR; PG8_SCHED;
            } else {
            PG8_LDB(B0, 0, 0); PG8_SCHED; PG8_LDA(At, 0, 0); PG8_STAGE(PG8_SA(1, 1), a1 + hstepA, voffA);
            PG8_WAIT_L(8); PG8_BAR; PG8_WAIT_L(0); PG8_MMA(0, 0, At, B0); PG8_BAR; PG8_SCHED;
            PG8_LDB(B1, 0, 1); PG8_STAGE(PG8_SB(0, 0), b2, voffB);
            PG8_BAR; PG8_WAIT_L(0); PG8_MMA(0, 1, At, B1); PG8_BAR;
            PG8_LDA(At, 0, 1); PG8_STAGE(PG8_SA(0, 0), a2, voffA);
            PG8_BAR; PG8_WAIT_L(0); PG8_MMA(1, 0, At, B0); PG8_BAR; PG8_SCHED;
            PG8_STAGE(PG8_SB(0, 1), b2 + hstepB, voffB);
            PG8_WAIT_V(6); PG8_BAR; PG8_MMA(1, 1, At, B1); PG8_BAR;
            PG8_LDB(B0, 1, 0); PG8_SCHED; PG8_LDA(At, 1, 0); PG8_STAGE(PG8_SA(0, 1), a2 + hstepA, voffA);
            PG8_WAIT_L(8); PG8_BAR; PG8_WAIT_L(0); PG8_MMA(0, 0, At, B0); PG8_BAR; PG8_SCHED;
            PG8_LDB(B1, 1, 1); PG8_STAGE(PG8_SB(1, 0), b3, voffB);
            PG8_BAR; PG8_WAIT_L(0); PG8_MMA(0, 1, At, B1); PG8_BAR;
            PG8_LDA(At, 1, 1); PG8_STAGE(PG8_SA(1, 0), a3, voffA);
            PG8_BAR; PG8_WAIT_L(0); PG8_MMA(1, 0, At, B0); PG8_BAR; PG8_SCHED;
            PG8_STAGE(PG8_SB(1, 1), b3 + hstepB, voffB);
            PG8_WAIT_V(6); PG8_BAR; PG8_MMA(1, 1, At, B1); PG8_BAR;
            }
        }
        if constexpr (ALIGN_EPI) { if (wr == 0) PG8_BAR; }
        const bool keep = E(acc, cur, wr, wc, fr, fq);
        if (!has_next) break;
        if (!keep) {
#pragma unroll
        for (int a = 0; a < 2; ++a)
#pragma unroll
            for (int b = 0; b < 2; ++b)
#pragma unroll
                for (int m = 0; m < 4; ++m)
#pragma unroll
                    for (int n = 0; n < 2; ++n) acc[a][b][m][n] = (f32x4){0.f, 0.f, 0.f, 0.f};
        }
        cur = nxt; cA = nA; cB = nB; ++ui; nt = __builtin_amdgcn_readfirstlane(P.nt(cur)); asm volatile("" : "+s"(nt));
        if constexpr (ALIGN_EPI) { if (wr == 1) PG8_BAR; }
    }
    PG8_WAIT_V(0);
    if constexpr (!ALIGN_EPI) { if (wr == 0) PG8_BAR; }
    PG8_BAR;
#undef PG8_SA
#undef PG8_SB
#undef PG8_STAGE
#undef PG8_LDA
#undef PG8_LDB
#undef PG8_MMA
#undef PG8_WAIT_V
#undef PG8_WAIT_L
#undef PG8_BAR
#undef PG8_SCHED
}

typedef f32x4 Acc[2][2][4][2];
__device__ __forceinline__ void store8(bf16_t* p, f32x4 v0, f32x4 v1) { u32x4 w; w.x = cvtpk(v0[0], v0[1]); w.y = cvtpk(v0[2], v0[3]); w.z = cvtpk(v1[0], v1[1]); w.w = cvtpk(v1[2], v1[3]); *(u32x4*)p = w; }

struct EpiProj {
    static constexpr bool PERM = true;
    bf16_t* proj; bf16_t* y; float* ssq; bf16_t* kr; const float* cs;
    __device__ __forceinline__ bool operator()(Acc& acc, const Unit& u, int wr, int wc, int fr, int fq) const {
        const bool act = u.pn >= 8;
        bf16_t* base = act ? y + (u.pn - 8) * 256 : proj + u.pn * 256; const int ld = act ? YLD : PLD;
        const int row0 = u.pm * BM + wr * 64 + fr, col0 = wc * 32 + 8 * fq;
#pragma unroll
        for (int ai = 0; ai < 2; ++ai)
#pragma unroll
            for (int m = 0; m < 4; ++m) { bf16_t* rowp = base + (size_t)(row0 + ai * HALF + m * 16) * ld + col0;
#pragma unroll
                for (int bj = 0; bj < 2; ++bj) { f32x4 v0 = acc[ai][bj][m][0], v1 = acc[ai][bj][m][1];
                    if (act) {
#pragma unroll
                        for (int e = 0; e < 4; ++e) { v0[e] = silu_f(v0[e]); v1[e] = silu_f(v1[e]); } }
                    store8(rowp + bj * HALF, v0, v1); } }
        if (u.pn == 2 || u.pn == 3) {
            float* sq = ssq + (u.pn == 3 ? (size_t)M * 4 : 0);
#pragma unroll
            for (int ai = 0; ai < 2; ++ai)
#pragma unroll
                for (int m = 0; m < 4; ++m) { float s = 0.f;
#pragma unroll
                    for (int bj = 0; bj < 2; ++bj) if (bj == 0 || u.pn == 2) {
#pragma unroll
                        for (int n = 0; n < 2; ++n) { const f32x4 x = acc[ai][bj][m][n]; s += (x[0] * x[0] + x[1] * x[1]) + (x[2] * x[2] + x[3] * x[3]); } }
                    s += __shfl_xor(s, 16); s += __shfl_xor(s, 32);
                    if (fq == 0) sq[(size_t)(row0 + ai * HALF + m * 16) * 4 + wc] = s; }
        }
        if (u.pn == 3 && wc == 0) {
#pragma unroll
            for (int ai = 0; ai < 2; ++ai)
#pragma unroll
                for (int m = 0; m < 4; ++m) { const size_t row = (size_t)(row0 + ai * HALF + m * 16);
                    float own[8], oth[8];
#pragma unroll
                    for (int e = 0; e < 4; ++e) { own[e] = acc[ai][1][m][0][e]; own[4 + e] = acc[ai][1][m][1][e]; }
#pragma unroll
                    for (int e = 0; e < 8; ++e) { auto rr = __builtin_amdgcn_permlane32_swap(__float_as_uint(own[e]), __float_as_uint(own[e]), false, false); oth[e] = __uint_as_float(fq < 2 ? rr[1] : rr[0]); }
                    if (fq < 2) { const float* c = cs + row * 32 + 16 * fq; u32x4 w0, w1;
                        const f32x4 c0 = *(const f32x4*)c, c1 = *(const f32x4*)(c + 4), c2 = *(const f32x4*)(c + 8), c3 = *(const f32x4*)(c + 12);
                        w0.x = cvtpk(own[0] * c0[0] - oth[0] * c0[1], oth[0] * c0[0] + own[0] * c0[1]); w0.y = cvtpk(own[1] * c0[2] - oth[1] * c0[3], oth[1] * c0[2] + own[1] * c0[3]);
                        w0.z = cvtpk(own[2] * c1[0] - oth[2] * c1[1], oth[2] * c1[0] + own[2] * c1[1]); w0.w = cvtpk(own[3] * c1[2] - oth[3] * c1[3], oth[3] * c1[2] + own[3] * c1[3]);
                        w1.x = cvtpk(own[4] * c2[0] - oth[4] * c2[1], oth[4] * c2[0] + own[4] * c2[1]); w1.y = cvtpk(own[5] * c2[2] - oth[5] * c2[3], oth[5] * c2[2] + own[5] * c2[3]);
                        w1.z = cvtpk(own[6] * c3[0] - oth[6] * c3[1], oth[6] * c3[0] + own[6] * c3[1]); w1.w = cvtpk(own[7] * c3[2] - oth[7] * c3[3], oth[7] * c3[2] + own[7] * c3[3]);
                        *(u32x4*)(kr + row * 32 + 16 * fq) = w0; *(u32x4*)(kr + row * 32 + 16 * fq + 8) = w1; } }
        }
        return false;
    }
};
struct EpiGate {
    static constexpr bool PERM = true;
    bf16_t* g; const float* bias;
    __device__ __forceinline__ bool operator()(Acc& acc, const Unit& u, int wr, int wc, int fr, int fq) const {
        const int row0 = u.pm * BM + wr * 64 + fr, col0 = u.pn * BM + wc * 32 + 8 * fq;
        f32x4 bv[2][2];
#pragma unroll
        for (int bj = 0; bj < 2; ++bj)
#pragma unroll
            for (int n = 0; n < 2; ++n) bv[bj][n] = *(const f32x4*)(bias + col0 + bj * HALF + 4 * n);
#pragma unroll
        for (int ai = 0; ai < 2; ++ai)
#pragma unroll
            for (int m = 0; m < 4; ++m) { bf16_t* rowp = g + (size_t)(row0 + ai * HALF + m * 16) * GLD + col0;
#pragma unroll
                for (int bj = 0; bj < 2; ++bj) { f32x4 v0 = acc[ai][bj][m][0] + bv[bj][0], v1 = acc[ai][bj][m][1] + bv[bj][1];
#pragma unroll
                    for (int e = 0; e < 4; ++e) { v0[e] = sigmoid_f(v0[e]); v1[e] = sigmoid_f(v1[e]); }
                    store8(rowp + bj * HALF, v0, v1); } }
        return false;
    }
};
struct EpiQ {
    static constexpr bool PERM = true;
    bf16_t* q; const float* cs; const float* ssq;
    __device__ __forceinline__ bool operator()(Acc& acc, const Unit& u, int wr, int wc, int fr, int fq) const {
        const int row0 = u.pm * BM + wr * 64 + fr, col0 = u.pn * BM + wc * 32 + 8 * fq;
#pragma unroll
        for (int ai = 0; ai < 2; ++ai)
#pragma unroll
            for (int m = 0; m < 4; ++m) { const int row = row0 + ai * HALF + m * 16; bf16_t* rowp = q + (size_t)row * QLD + col0;
                const f32x4 sq = *(const f32x4*)(ssq + (size_t)row * 4); const float rstd = QSCALE / sqrtf(((sq[0] + sq[1]) + (sq[2] + sq[3])) * (1.f / 256.f) + EPS);
#pragma unroll
                for (int bj = 0; bj < 2; ++bj) { f32x4 v0 = acc[ai][bj][m][0], v1 = acc[ai][bj][m][1];
                    const int d = (col0 + bj * HALF) % 96;
                    if (d >= 64) { const float* c = cs + (size_t)row * 32 + (d - 64); const f32x4 c0 = *(const f32x4*)c, c1 = *(const f32x4*)(c + 4);
                        f32x4 o0, o1;
                        o0[0] = v0[0] * c0[0] - v0[1] * c0[1]; o0[1] = v0[1] * c0[0] + v0[0] * c0[1];
                        o0[2] = v0[2] * c0[2] - v0[3] * c0[3]; o0[3] = v0[3] * c0[2] + v0[2] * c0[3];
                        o1[0] = v1[0] * c1[0] - v1[1] * c1[1]; o1[1] = v1[1] * c1[0] + v1[0] * c1[1];
                        o1[2] = v1[2] * c1[2] - v1[3] * c1[3]; o1[3] = v1[3] * c1[2] + v1[2] * c1[3];
                        v0 = o0; v1 = o1; }
                    store8(rowp + bj * HALF, v0 * rstd, v1 * rstd); } }
        return false;
    }
};
struct EpiKV {
    static constexpr bool PERM = true;
    bf16_t* k; bf16_t* v; const float* ssq;
    __device__ __forceinline__ bool operator()(Acc& acc, const Unit& u, int wr, int wc, int fr, int fq) const {
        const int row0 = u.pm * BM + wr * 64 + fr, col0 = u.pn * BM + wc * 32 + 8 * fq;
#pragma unroll
        for (int ai = 0; ai < 2; ++ai)
#pragma unroll
            for (int m = 0; m < 4; ++m) { const int row = row0 + ai * HALF + m * 16;
                const f32x4 sq = *(const f32x4*)(ssq + (size_t)row * 4); const float rstd = 1.f / sqrtf(((sq[0] + sq[1]) + (sq[2] + sq[3])) * (1.f / 128.f) + EPS);
#pragma unroll
                for (int bj = 0; bj < 2; ++bj) { const int c = col0 + bj * HALF, head = c >> 7, d = c & 127;
                    bf16_t* p = d < 64 ? k + (size_t)row * KLD + head * 64 + d : v + (size_t)row * VLD + head * 64 + (d - 64);
                    store8(p, acc[ai][bj][m][0] * rstd, acc[ai][bj][m][1] * rstd); } }
        return false;
    }
};
struct EpiPlain {
    static constexpr bool PERM = true;
    bf16_t* o; int ld;
    __device__ __forceinline__ bool operator()(Acc& acc, const Unit& u, int wr, int wc, int fr, int fq) const {
        const int row0 = u.pm * BM + wr * 64 + fr, col0 = u.pn * BM + wc * 32 + 8 * fq;
#pragma unroll
        for (int ai = 0; ai < 2; ++ai)
#pragma unroll
            for (int m = 0; m < 4; ++m) { bf16_t* rowp = o + (size_t)(row0 + ai * HALF + m * 16) * ld + col0;
#pragma unroll
                for (int bj = 0; bj < 2; ++bj) store8(rowp + bj * HALF, acc[ai][bj][m][0], acc[ai][bj][m][1]); }
        return false;
    }
};
struct EpiMix {
    static constexpr bool PERM = true;
    bf16_t* k; bf16_t* v; bf16_t* q; bf16_t* pl; const float* cs; const float* ssq;
    __device__ __forceinline__ bool operator()(Acc& acc, const Unit& u, int wr, int wc, int fr, int fq) const {
        if (u.br == 0) { const EpiKV e{k, v, ssq + (size_t)M * 4}; e(acc, u, wr, wc, fr, fq); }
        else if (u.br == 1) { const EpiQ e{q, cs, ssq}; e(acc, u, wr, wc, fr, fq); }
        else { const EpiPlain e{pl, PLD}; e(acc, u, wr, wc, fr, fq); }
        return false;
    }
};
struct EpiMerge {
    static constexpr bool PERM = true;
    const bf16_t* g; bf16_t* o;
    __device__ __forceinline__ bool operator()(Acc& acc, const Unit& u, int wr, int wc, int fr, int fq) const {
        const int row0 = u.pm * BM + wr * 64 + fr, col0 = u.pn * BM + wc * 32 + 8 * fq;
        const bool fin = u.br == 2;
#pragma unroll
        for (int ai = 0; ai < 2; ++ai)
#pragma unroll
            for (int m = 0; m < 4; ++m) { const size_t row = (size_t)(row0 + ai * HALF + m * 16);
#pragma unroll
                for (int bj = 0; bj < 2; ++bj) {
                    const u32x4 ga = *(const u32x4*)(g + row * GLD + u.br * 1024 + col0 + bj * HALF);
                    float f[8] = {bf_lo(ga.x), bf_hi(ga.x), bf_lo(ga.y), bf_hi(ga.y), bf_lo(ga.z), bf_hi(ga.z), bf_lo(ga.w), bf_hi(ga.w)};
                    if (!fin) { const u32x4 gb = *(const u32x4*)(g + row * GLD + (u.br + 1) * 1024 + col0 + bj * HALF);
                        const float h[8] = {bf_lo(gb.x), bf_hi(gb.x), bf_lo(gb.y), bf_hi(gb.y), bf_lo(gb.z), bf_hi(gb.z), bf_lo(gb.w), bf_hi(gb.w)};
#pragma unroll
                        for (int e = 0; e < 8; ++e) f[e] *= __builtin_amdgcn_rcpf(h[e]); }
                    f32x4 v0 = acc[ai][bj][m][0], v1 = acc[ai][bj][m][1];
#pragma unroll
                    for (int e = 0; e < 4; ++e) { v0[e] *= f[e]; v1[e] *= f[4 + e]; }
                    if (fin) store8(o + row * DM + col0 + bj * HALF, v0, v1);
                    else { acc[ai][bj][m][0] = v0; acc[ai][bj][m][1] = v1; } } }
        return !fin;
    }
};
struct EpiZ {
    static constexpr bool PERM = false;
    float* z;
    __device__ __forceinline__ bool operator()(Acc& acc, const Unit& u, int wr, int wc, int fr, int fq) const {
        const int row0 = u.pm * BM + wr * 64 + fr, col0 = u.pn * BM + wc * 32 + 4 * fq;
#pragma unroll
        for (int ai = 0; ai < 2; ++ai)
#pragma unroll
            for (int m = 0; m < 4; ++m) { float* rowp = z + (size_t)(row0 + ai * HALF + m * 16) * DM + col0;
#pragma unroll
                for (int bj = 0; bj < 2; ++bj)
#pragma unroll
                    for (int n = 0; n < 2; ++n) *(f32x4*)(rowp + bj * HALF + n * 16) = acc[ai][bj][m][n]; }
        return false;
    }
};
}

namespace att {
constexpr int NW = 8, QBLK = 32, QB = 256, KVBLK = 64;
constexpr int KSLOT = 12288, VSLOT = 8192;
constexpr int LDS_K = 0, LDS_V = 2 * KSLOT, LDS_WS = LDS_V + 2 * VSLOT, LDS_OST = LDS_WS + NW * 256, LDS_BYTES = LDS_OST + NW * 4096;
__device__ __forceinline__ int crow(int r, int hi) { return (r & 3) + 8 * (r >> 2) + 4 * hi; }
__device__ __forceinline__ void glds16(const void* gsrc, unsigned lds_dst) { unsigned keep;
    asm volatile("s_mov_b32 %0, m0\n\ts_mov_b32 m0, %2\n\ts_nop 0\n\tglobal_load_lds_dwordx4 %1, off\n\ts_mov_b32 m0, %0" : "=&s"(keep) : "v"(gsrc), "s"(lds_dst) : "memory"); }
#define ATT_WAIT_BAR(N) asm volatile("s_waitcnt vmcnt(" #N ") lgkmcnt(0)\n\ts_barrier" ::: "memory")
typedef LAS const char* lds_cptr;
typedef short v4i16_t __attribute__((ext_vector_type(4)));
__device__ __forceinline__ s16x4 vtr(lds_cptr p) { return __builtin_bit_cast(s16x4, __builtin_amdgcn_ds_read_tr16_b64_v4i16((LAS v4i16_t*)p)); }
__device__ __forceinline__ float rowmax32(const f32x16& p0, const f32x16& p1) {
    float a = fmaxf(p0[0], p1[0]);
#pragma unroll
    for (int r = 1; r < 16; ++r) a = fmaxf(a, fmaxf(p0[r], p1[r]));
    auto rr = __builtin_amdgcn_permlane32_swap(__float_as_uint(a), __float_as_uint(a), false, false);
    return fmaxf(__uint_as_float(rr[0]), __uint_as_float(rr[1]));
}

__device__ __forceinline__ void attn_unit(int b, int h, int qb, const bf16_t* Q, const bf16_t* K, const bf16_t* KR, const bf16_t* V, bf16_t* Y, LAS char* shm, unsigned lds0) {
    int tid = threadIdx.x; asm volatile("" : "+v"(tid));
    const int lane = tid & 63, r32 = lane & 31, hi = lane >> 5; const int wid = __builtin_amdgcn_readfirstlane(tid >> 6);
    const long rowbase = (long)b * SEQ; const int q0 = qb * QB;
    const bf16_t* Qw = Q + (rowbase + q0 + wid * QBLK) * QLD + h * 96;
    const bf16_t* Kh = K + rowbase * KLD + h * 64; const bf16_t* Vh = V + rowbase * VLD + h * 64;
    LAS float* wsf = (LAS float*)(shm + LDS_WS) + wid * 64;
    const int c2 = 8 + (wid & 3);
    const bf16_t* ksrc0 = Kh + (long)lane * KLD + wid * 8; const bf16_t* ksrc1 = KR + (rowbase + lane) * 32 + (c2 - 8) * 8;
    const bf16_t* vsrc = Vh + (long)(16 * (wid & 3) + (lane >> 2)) * VLD + (wid >> 2) * 32 + (lane & 3) * 8;
    const unsigned kdst0 = lds0 + LDS_K + wid * 1024, kdst1 = lds0 + LDS_K + c2 * 1024, vdst = lds0 + LDS_V + wid * 1024;
#define ATT_DMA(t, s) do { glds16(ksrc0 + (long)(t) * KVBLK * KLD, (unsigned)__builtin_amdgcn_readfirstlane(kdst0 + (s) * KSLOT)); \
                           glds16(ksrc1 + (long)(t) * KVBLK * 32, (unsigned)__builtin_amdgcn_readfirstlane(kdst1 + (s) * KSLOT)); \
                           glds16(vsrc + (long)(t) * KVBLK * VLD, (unsigned)__builtin_amdgcn_readfirstlane(vdst + (s) * VSLOT)); } while (0)
    const int NT = (q0 + QB) / KVBLK;
    ATT_DMA(0, 0);
    bf16x8 qr[6];
#pragma unroll
    for (int d0 = 0; d0 < 6; ++d0) qr[d0] = *(const bf16x8*)(Qw + (long)r32 * QLD + d0 * 16 + hi * 8);
    float mrow = -1e30f, l_reg = 0.f; f32x16 o[2]; o[0] = f32x16{}; o[1] = f32x16{};
    const int qrel = wid * QBLK + r32;
    const lds_cptr kp0 = (lds_cptr)shm + LDS_K + hi * 1024 + r32 * 16;
    const lds_cptr vp0 = (lds_cptr)shm + LDS_V + ((lane >> 4) & 1) * 32 + (lane & 3) * 8 + (4 * hi + ((lane & 15) >> 2)) * 64;
    for (int t = 0; t < NT; ++t) {
        ATT_WAIT_BAR(0);
        if (t + 1 < NT) ATT_DMA(t + 1, (t + 1) & 1);
        const lds_cptr kp = kp0 + (t & 1) * KSLOT; const lds_cptr vp = vp0 + (t & 1) * VSLOT;
        f32x16 p0 = f32x16{}, p1 = f32x16{};
#pragma unroll
        for (int d0 = 0; d0 < 6; ++d0) {
            const bf16x8 k0 = *(const LAS bf16x8*)(kp + d0 * 2048), k1 = *(const LAS bf16x8*)(kp + d0 * 2048 + 512);
            p0 = __builtin_amdgcn_mfma_f32_32x32x16_bf16(k0, qr[d0], p0, 0, 0, 0);
            p1 = __builtin_amdgcn_mfma_f32_32x32x16_bf16(k1, qr[d0], p1, 0, 0, 0);
        }
        const int jb = t - (NT - 4);
        if (jb >= 0) { const int kb = 64 * jb + 4 * hi;
#pragma unroll
            for (int r = 0; r < 16; ++r) { const int kv = kb + (r & 3) + 8 * (r >> 2); if (kv > qrel) p0[r] = -INFINITY; if (kv + 32 > qrel) p1[r] = -INFINITY; } }
        const float rm = rowmax32(p0, p1);
        const float mn = fmaxf(mrow, rm), alpha = __builtin_amdgcn_exp2f(mrow - mn);
        mrow = mn;
        float ls = 0.f;
#pragma unroll
        for (int r = 0; r < 16; ++r) { p0[r] = __builtin_amdgcn_exp2f(p0[r] - mn); p1[r] = __builtin_amdgcn_exp2f(p1[r] - mn); ls += p0[r] + p1[r]; }
        l_reg = l_reg * alpha + ls;
        if (__any(alpha != 1.f)) {
            if (hi == 0) wsf[r32] = alpha;
            LDS_WAIT();
#pragma unroll
            for (int r = 0; r < 16; ++r) { const float f = wsf[crow(r, hi)]; o[0][r] *= f; o[1][r] *= f; }
            LDS_WAIT();
        }
        u32x4 pw[4];
        pw[0] = (u32x4){cvtpk(p0[0], p0[1]), cvtpk(p0[2], p0[3]), cvtpk(p0[4], p0[5]), cvtpk(p0[6], p0[7])};
        pw[1] = (u32x4){cvtpk(p0[8], p0[9]), cvtpk(p0[10], p0[11]), cvtpk(p0[12], p0[13]), cvtpk(p0[14], p0[15])};
        pw[2] = (u32x4){cvtpk(p1[0], p1[1]), cvtpk(p1[2], p1[3]), cvtpk(p1[4], p1[5]), cvtpk(p1[6], p1[7])};
        pw[3] = (u32x4){cvtpk(p1[8], p1[9]), cvtpk(p1[10], p1[11]), cvtpk(p1[12], p1[13]), cvtpk(p1[14], p1[15])};
#pragma unroll
        for (int d0 = 0; d0 < 2; ++d0)
#pragma unroll
            for (int ks = 0; ks < 4; ++ks) {
                const s16x4 lo = vtr(vp + d0 * 4096 + ks * 1024), hh = vtr(vp + d0 * 4096 + ks * 1024 + 512);
                const bf16x8 vf = (bf16x8){lo[0], lo[1], lo[2], lo[3], hh[0], hh[1], hh[2], hh[3]};
                o[d0] = __builtin_amdgcn_mfma_f32_32x32x16_bf16(__builtin_bit_cast(bf16x8, pw[ks]), vf, o[d0], 0, 0, 0);
            }
    }
    { auto rr = __builtin_amdgcn_permlane32_swap(__float_as_uint(l_reg), __float_as_uint(l_reg), false, false); l_reg = __uint_as_float(rr[0]) + __uint_as_float(rr[1]); }
    if (hi == 0) wsf[32 + r32] = l_reg; LDS_WAIT();
    float rli[16];
#pragma unroll
    for (int r = 0; r < 16; ++r) rli[r] = __builtin_amdgcn_rcpf(wsf[32 + crow(r, hi)]);
    bf16_t* Yw = Y + (rowbase + q0 + wid * QBLK) * YLD + 512 + h * 64;
    { LAS bf16_t* stg = (LAS bf16_t*)(shm + LDS_OST) + wid * 2048;
#pragma unroll
      for (int r = 0; r < 16; ++r) { const int orow = crow(r, hi);
#pragma unroll
          for (int d0 = 0; d0 < 2; ++d0) stg[orow * 64 + d0 * 32 + r32] = f2bf(o[d0][r] * rli[r]); }
      LDS_WAIT();
#pragma unroll
      for (int i = 0; i < 4; ++i) { const int row = i * 8 + (lane >> 3), ch = lane & 7; const u32x4 v = *(const LAS u32x4*)(stg + row * 64 + ch * 8);
          bf16_t* gp = Yw + (long)row * YLD + ch * 8; const u32x4 gt = *(const u32x4*)gp; u32x4 w;
          w.x = cvtpk(bf_lo(v.x) * bf_lo(gt.x), bf_hi(v.x) * bf_hi(gt.x)); w.y = cvtpk(bf_lo(v.y) * bf_lo(gt.y), bf_hi(v.y) * bf_hi(gt.y));
          w.z = cvtpk(bf_lo(v.z) * bf_lo(gt.z), bf_hi(v.z) * bf_hi(gt.z)); w.w = cvtpk(bf_lo(v.w) * bf_lo(gt.w), bf_hi(v.w) * bf_hi(gt.w));
          *(u32x4*)gp = w; }
      LDS_WAIT(); }
#undef ATT_DMA
}
}

namespace att2 {
using att::crow; using att::glds16; using att::lds_cptr; using att::vtr;
constexpr int NW = 8, QBLK = 32, QB = 256, KVBLK = 64;
constexpr int KSLOT = 12288, VSLOT = 8192, NKS = 4, NVS = 3;
constexpr int LDS_K = 0, LDS_V = NKS * KSLOT, LDS_WS = LDS_V + NVS * VSLOT, LDS_OST = LDS_WS + NW * 256, LDS_BYTES = LDS_OST + NW * 4096;
#define SBAR() __builtin_amdgcn_sched_barrier(0)
#define WAIT_BAR(N) asm volatile("s_waitcnt vmcnt(" #N ") lgkmcnt(0)\n\ts_barrier" ::: "memory")
__device__ __forceinline__ float max3f(float a, float b, float c) { float r; asm("v_max3_f32 %0, %1, %2, %3" : "=v"(r) : "v"(a), "v"(b), "v"(c)); return r; }
__device__ __forceinline__ float max2f(float a, float b) { float r; asm("v_max_f32_e32 %0, %1, %2" : "=v"(r) : "v"(a), "v"(b)); return r; }
__device__ __forceinline__ float fadd_s(float a, float b) { float r; asm("v_add_f32_e32 %0, %1, %2" : "=v"(r) : "v"(a), "v"(b)); return r; }
__device__ __forceinline__ float fsub_s(float a, float b) { float r; asm("v_sub_f32_e32 %0, %1, %2" : "=v"(r) : "v"(a), "v"(b)); return r; }
__device__ __forceinline__ void cmask(f32x16& p0, f32x16& p1, int jb, int qrel, int hi) {
    const float NEG = -INFINITY; const int kb = 64 * jb + 4 * hi;
#pragma unroll
    for (int r = 0; r < 16; ++r) { const int kv = kb + (r & 3) + 8 * (r >> 2); if (kv > qrel) p0[r] = NEG; if (kv + 32 > qrel) p1[r] = NEG; }
}
__device__ __forceinline__ void qkt(f32x16& p0, f32x16& p1, lds_cptr kb, const bf16x8* qr, const f32x16& negm) {
#pragma unroll
    for (int d0 = 0; d0 < 6; ++d0) {
        const bf16x8 b0 = *(const LAS bf16x8*)(kb + d0 * 2048), b1 = *(const LAS bf16x8*)(kb + d0 * 2048 + 512);
        if (d0 == 0) { p0 = __builtin_amdgcn_mfma_f32_32x32x16_bf16(b0, qr[0], negm, 0, 0, 0); p1 = __builtin_amdgcn_mfma_f32_32x32x16_bf16(b1, qr[0], negm, 0, 0, 0); }
        else { p0 = __builtin_amdgcn_mfma_f32_32x32x16_bf16(b0, qr[d0], p0, 0, 0, 0); p1 = __builtin_amdgcn_mfma_f32_32x32x16_bf16(b1, qr[d0], p1, 0, 0, 0); } }
}
__device__ __forceinline__ void kload2(bf16x8* kf, lds_cptr kp, int j, int d0) { kf[2 * j] = *(const LAS bf16x8*)(kp + d0 * 2048); kf[2 * j + 1] = *(const LAS bf16x8*)(kp + d0 * 2048 + 512); }
__device__ __forceinline__ float rowmax(const f32x16& p0, const f32x16& p1) {
    float a = max3f(p0[0], p0[1], p1[0]), b = max3f(p0[2], p0[3], p1[1]); a = max3f(a, p1[2], p1[3]);
#pragma unroll
    for (int r = 4; r < 16; r += 4) { a = max3f(a, p0[r], p0[r + 1]); b = max3f(b, p0[r + 2], p0[r + 3]); a = max3f(a, p1[r], p1[r + 1]); b = max3f(b, p1[r + 2], p1[r + 3]); }
    const float m = max2f(a, b);
    auto rr = __builtin_amdgcn_permlane32_swap(__float_as_uint(m), __float_as_uint(m), false, false);
    return max2f(__uint_as_float(rr[0]), __uint_as_float(rr[1]));
}
__device__ __forceinline__ void pv(f32x16* o, lds_cptr vp, bf16x8 pa0, bf16x8 pa1, bf16x8 pa2, bf16x8 pa3) {
#pragma unroll
    for (int d0 = 0; d0 < 2; ++d0) { s16x4 lo[4], hh[4];
#pragma unroll
        for (int ks = 0; ks < 4; ++ks) { lo[ks] = vtr(vp + d0 * 4096 + ks * 1024); hh[ks] = vtr(vp + d0 * 4096 + ks * 1024 + 512); }
#define PK(k) (bf16x8){lo[k][0], lo[k][1], lo[k][2], lo[k][3], hh[k][0], hh[k][1], hh[k][2], hh[k][3]}
        o[d0] = __builtin_amdgcn_mfma_f32_32x32x16_bf16(pa0, PK(0), o[d0], 0, 0, 0);
        o[d0] = __builtin_amdgcn_mfma_f32_32x32x16_bf16(pa1, PK(1), o[d0], 0, 0, 0);
        o[d0] = __builtin_amdgcn_mfma_f32_32x32x16_bf16(pa2, PK(2), o[d0], 0, 0, 0);
        o[d0] = __builtin_amdgcn_mfma_f32_32x32x16_bf16(pa3, PK(3), o[d0], 0, 0, 0);
#undef PK
    }
}

template <int THRL> __device__ __forceinline__ void attn_unit(int b, int h, int qb, const bf16_t* Q, const bf16_t* __restrict__ K, const bf16_t* __restrict__ KR, const bf16_t* __restrict__ V, bf16_t* Y, LAS char* shm, unsigned lds0, bool dry = false) {
    int tid = threadIdx.x; asm volatile("" : "+v"(tid));
    const int lane = tid & 63, r32 = lane & 31, hi = lane >> 5; const int wid = __builtin_amdgcn_readfirstlane(tid >> 6);
    const long rowbase = (long)b * SEQ; const int q0 = qb * QB;
    const bf16_t* Qw = Q + (rowbase + q0 + wid * QBLK) * QLD + h * 96;
    const bf16_t* Kh = K + rowbase * KLD + h * 64; const bf16_t* Vh = V + rowbase * VLD + h * 64;
    LAS float* wsf = (LAS float*)(shm + LDS_WS) + wid * 64;
    const int c2 = 8 + (wid & 3);
    const bf16_t* ksrc0 = Kh + (long)lane * KLD + wid * 8; const bf16_t* ksrc1 = KR + (rowbase + lane) * 32 + (c2 - 8) * 8;
    const bf16_t* vsrc = Vh + (long)(16 * (wid & 3) + (lane >> 2)) * VLD + (wid >> 2) * 32 + (lane & 3) * 8;
    const unsigned kdst0 = lds0 + LDS_K + wid * 1024, kdst1 = lds0 + LDS_K + c2 * 1024, vdst = lds0 + LDS_V + wid * 1024;
#define DMA_K(t, slot) do { glds16(ksrc0 + (long)(t) * KVBLK * KLD, (unsigned)__builtin_amdgcn_readfirstlane(kdst0 + (slot))); glds16(ksrc1 + (long)(t) * KVBLK * 32, (unsigned)__builtin_amdgcn_readfirstlane(kdst1 + (slot))); } while (0)
#define DMA_V(t, slot) glds16(vsrc + (long)(t) * KVBLK * VLD, (unsigned)__builtin_amdgcn_readfirstlane(vdst + (slot)))
    const lds_cptr shm3 = (lds_cptr)shm; const lds_cptr kp0 = shm3 + LDS_K + hi * 1024 + r32 * 16;
    const lds_cptr vp0 = shm3 + LDS_V + ((lane >> 4) & 1) * 32 + (lane & 3) * 8 + (4 * hi + ((lane & 15) >> 2)) * 64;
    bf16x8 kf[8];
    const int NT = (q0 + QB) / KVBLK;
    DMA_K(0, 0); DMA_V(0, 0); DMA_K(1, KSLOT);
    bf16x8 qr[6];
#pragma unroll
    for (int d0 = 0; d0 < 6; ++d0) qr[d0] = *(const bf16x8*)(Qw + (long)r32 * QLD + d0 * 16 + hi * 8);
    float mhat = 0.f, l_reg = 0.f; f32x16 o[2]; o[0] = f32x16{}; o[1] = f32x16{}; f32x16 negm = f32x16{}; asm volatile("" : "+v"(negm));
    const int qrel = wid * QBLK + r32;
#define CMASK(P0, P1, t) do { int jb_ = (t) - (NT - 4); if (jb_ >= 0) cmask(P0, P1, jb_, qrel, hi); } while (0)
    bool resc = false;
#define START(P0, P1) do { const float rm = rowmax(P0, P1); resc = false; \
    { const float dl = rm; mhat = fadd_s(mhat, dl); \
      _Pragma("unroll") for (int r = 0; r < 16; ++r) { P0[r] = fsub_s(P0[r], dl); P1[r] = fsub_s(P1[r], dl); } \
      _Pragma("unroll") for (int r = 0; r < 16; ++r) negm[r] = -mhat; asm volatile("" : "+v"(negm)); } \
    _Pragma("unroll") for (int r = 0; r < 16; ++r) P0[r] = __builtin_amdgcn_exp2f(P0[r]); } while (0)
#define RESC() do { if (resc) { asm volatile("s_waitcnt lgkmcnt(0)" ::: "memory"); \
      _Pragma("unroll") for (int d_ = 0; d_ < 2; ++d_) _Pragma("unroll") for (int r = 0; r < 16; ++r) o[d_][r] *= wsf[crow(r, hi)]; } } while (0)
    f32x16 pA0, pA1, pB0, pB1;
    int sk_prev = 0, sk_cur = 0, sk_next = KSLOT, sv_prev = 0, sv_cur = 0, sv_next = VSLOT;
#define ROT() do { sk_prev = sk_cur; sk_cur = sk_next; sk_next = (sk_next == (NKS - 1) * KSLOT) ? 0 : sk_next + KSLOT; \
                   sv_prev = sv_cur; sv_cur = sv_next; sv_next = (sv_next == (NVS - 1) * VSLOT) ? 0 : sv_next + VSLOT; } while (0)
    DMA_K(2, 2 * KSLOT);
    WAIT_BAR(2);
    qkt(pA0, pA1, kp0, qr, negm); asm volatile("s_nop 15\n\ts_nop 7" : "+v"(pA0), "+v"(pA1)); CMASK(pA0, pA1, 0);
    START(pA0, pA1);
#pragma unroll
    for (int r = 0; r < 16; ++r) pA1[r] = __builtin_amdgcn_exp2f(pA1[r]);
    WAIT_BAR(0);
    DMA_K(3, 3 * KSLOT); DMA_V(1, VSLOT);
    ROT();
#pragma unroll
    for (int j = 0; j < 4; ++j) kload2(kf, kp0 + sk_cur, j, j);
    s16x4 vlo[8], vhi[8]; u32x4 pw0, pw1, pw2, pw3;
#define PKW(P, B) cvtpk(P[B], P[B + 1])
#define PAF(k) __builtin_bit_cast(bf16x8, pw##k)
#define VFR(i) (bf16x8){vlo[i][0], vlo[i][1], vlo[i][2], vlo[i][3], vhi[i][0], vhi[i][1], vhi[i][2], vhi[i][3]}
#define PIN(x) asm volatile("" : "+v"(x))
#define MX3(a, b, c) __builtin_fmaxf(__builtin_fmaxf((a), (b)), (c))
#define MF32(a, b, c) __builtin_amdgcn_mfma_f32_32x32x16_bf16(a, b, c, 0, 0, 0)
#define GAPA(MF, A0, A1, W0, W1, PW) do { MF; sacc += A0; sacc += A1; PIN(sacc); W0; W1; PIN(PW); SBAR(); } while (0)
#define GAPC(MF, A0, A1, A2, A3) do { MF; sacc += A0; sacc += A1; sacc += A2; sacc += A3; PIN(sacc); SBAR(); } while (0)
#define EX(v) __builtin_amdgcn_exp2f(v)
#define GAPB(MF, X, B) do { MF; X[B] = EX(X[B]); X[B + 1] = EX(X[B + 1]); X[B + 2] = EX(X[B + 2]); X[B + 3] = EX(X[B + 3]); PIN(X); SBAR(); } while (0)
#define VRD(i) do { vlo[i] = vtr(vp_ + (((i) >> 2) * 4096 + ((i) & 3) * 1024)); vhi[i] = vtr(vp_ + (((i) >> 2) * 4096 + ((i) & 3) * 1024 + 512)); } while (0)
#define KRD(G, j) do { if (G) { kload2(kf, kp0 + sk_next, j, j); SBAR(); } } while (0)
#define STEP(C0, C1, P0, P1, t, GK, GV, GL) do { SBAR(); \
    const lds_cptr vp_ = vp0 + sv_prev; const lds_cptr kc_ = kp0 + sk_cur; \
    VRD(0); SBAR(); float sacc = (P0[0] + P0[1]); \
    GAPA(C0 = MF32(kf[0], qr[0], negm), P0[2], P0[3],   pw0[0] = PKW(P0, 0),  pw0[1] = PKW(P0, 2),  pw0); \
    VRD(4); SBAR(); GAPA(C1 = MF32(kf[1], qr[0], negm), P0[4], P0[5],   pw0[2] = PKW(P0, 4),  pw0[3] = PKW(P0, 6),  pw0); \
    kload2(kf, kc_, 0, 4); VRD(1); SBAR(); GAPA(C0 = MF32(kf[2], qr[1], C0), P0[6], P0[7],   pw1[0] = PKW(P0, 8),  pw1[1] = PKW(P0, 10), pw1); \
    VRD(5); SBAR(); GAPA(C1 = MF32(kf[3], qr[1], C1), P0[8], P0[9],   pw1[2] = PKW(P0, 12), pw1[3] = PKW(P0, 14), pw1); \
    kload2(kf, kc_, 1, 5); VRD(2); SBAR(); GAPA(C0 = MF32(kf[4], qr[2], C0), P0[10], P0[11], pw2[0] = PKW(P1, 0),  pw2[1] = PKW(P1, 2),  pw2); \
    VRD(6); SBAR(); GAPA(C1 = MF32(kf[5], qr[2], C1), P0[12], P0[13], pw2[2] = PKW(P1, 4),  pw2[3] = PKW(P1, 6),  pw2); \
    VRD(3); SBAR(); GAPA(C0 = MF32(kf[6], qr[3], C0), P0[14], P0[15], pw3[0] = PKW(P1, 8),  pw3[1] = PKW(P1, 10), pw3); \
    VRD(7); SBAR(); GAPA(C1 = MF32(kf[7], qr[3], C1), P1[0], P1[1],   pw3[2] = PKW(P1, 12), pw3[3] = PKW(P1, 14), pw3); \
    GAPC(C0 = MF32(kf[0], qr[4], C0), P1[2], P1[3], P1[4], P1[5]); \
    GAPC(C1 = MF32(kf[1], qr[4], C1), P1[6], P1[7], P1[8], P1[9]); \
    GAPC(C0 = MF32(kf[2], qr[5], C0), P1[10], P1[11], P1[12], P1[13]); \
    GAPC(C1 = MF32(kf[3], qr[5], C1), P1[14], P1[15], 0.f, 0.f); \
    l_reg += sacc; \
    if (GK) { DMA_K((t) + 3, sk_prev); } if (GV) { DMA_V((t) + 1, sv_next); } \
    CMASK(C0, C1, t); \
    { float a = MX3(C0[0], C0[1], C1[0]), b_ = MX3(C0[2], C0[3], C1[1]); a = MX3(a, C1[2], C1[3]); \
      _Pragma("unroll") for (int r = 4; r < 16; r += 4) { a = MX3(a, C0[r], C0[r + 1]); b_ = MX3(b_, C0[r + 2], C0[r + 3]); a = MX3(a, C1[r], C1[r + 1]); b_ = MX3(b_, C1[r + 2], C1[r + 3]); } \
      float rm = __builtin_fmaxf(a, b_); { auto rr = __builtin_amdgcn_permlane32_swap(__float_as_uint(rm), __float_as_uint(rm), false, false); rm = __builtin_fmaxf(__uint_as_float(rr[0]), __uint_as_float(rr[1])); } \
      resc = false; \
      if (__builtin_expect(__any(rm > (float)THRL), 0)) { const float dl = __builtin_fmaxf(rm, 0.f); mhat += dl; \
        _Pragma("unroll") for (int r = 0; r < 16; ++r) { C0[r] -= dl; C1[r] -= dl; } \
        _Pragma("unroll") for (int r = 0; r < 16; ++r) negm[r] = -mhat; asm volatile("" : "+v"(negm)); \
        const float f = __builtin_amdgcn_exp2f(-dl); l_reg *= f; if (hi == 0) wsf[r32] = f; resc = true; } } \
    SBAR(); \
    GAPB(o[0] = MF32(PAF(0), VFR(0), o[0]), C0, 0); \
    GAPB(o[1] = MF32(PAF(0), VFR(4), o[1]), C0, 4); \
    KRD(GL, 0); GAPB(o[0] = MF32(PAF(1), VFR(1), o[0]), C0, 8); \
    KRD(GL, 1); GAPB(o[1] = MF32(PAF(1), VFR(5), o[1]), C0, 12); \
    KRD(GL, 2); GAPB(o[0] = MF32(PAF(2), VFR(2), o[0]), C1, 0); \
    KRD(GL, 3); GAPB(o[1] = MF32(PAF(2), VFR(6), o[1]), C1, 4); \
    GAPB(o[0] = MF32(PAF(3), VFR(3), o[0]), C1, 8); \
    GAPB(o[1] = MF32(PAF(3), VFR(7), o[1]), C1, 12); \
    } while (0)
    int t = 1;
#undef CMASK
#define CMASK(P0, P1, t) do { } while (0)
    for (; t + 5 < NT; t += 2) {
        STEP(pB0, pB1, pA0, pA1, t, true, true, true);     WAIT_BAR(3); RESC(); ROT();
        STEP(pA0, pA1, pB0, pB1, t + 1, true, true, true); WAIT_BAR(3); RESC(); ROT();
    }
#undef CMASK
#define CMASK(P0, P1, t) do { int jb_ = (t) - (NT - 4); if (jb_ >= 0) cmask(P0, P1, jb_, qrel, hi); } while (0)
#define ENDW(tt) do { if ((tt) + 3 < NT) { WAIT_BAR(3); } else if ((tt) + 2 < NT) { WAIT_BAR(1); } else { WAIT_BAR(0); } } while (0)
    for (; t + 1 < NT; t += 2) {
        STEP(pB0, pB1, pA0, pA1, t, (t + 3 < NT), (t + 1 < NT), (t + 1 < NT));         ENDW(t);     RESC(); ROT();
        STEP(pA0, pA1, pB0, pB1, t + 1, (t + 4 < NT), (t + 2 < NT), (t + 2 < NT));     ENDW(t + 1); RESC(); ROT();
    }
    STEP(pB0, pB1, pA0, pA1, NT - 1, false, false, false); RESC();
    { float sacc = pB0[0] + pB0[1];
#pragma unroll
      for (int r = 2; r < 16; ++r) sacc += pB0[r];
#pragma unroll
      for (int r = 0; r < 16; ++r) sacc += pB1[r];
      l_reg += sacc;
      pw0 = (u32x4){PKW(pB0, 0), PKW(pB0, 2), PKW(pB0, 4), PKW(pB0, 6)}; pw1 = (u32x4){PKW(pB0, 8), PKW(pB0, 10), PKW(pB0, 12), PKW(pB0, 14)};
      pw2 = (u32x4){PKW(pB1, 0), PKW(pB1, 2), PKW(pB1, 4), PKW(pB1, 6)}; pw3 = (u32x4){PKW(pB1, 8), PKW(pB1, 10), PKW(pB1, 12), PKW(pB1, 14)};
      SBAR(); pv(o, vp0 + sv_cur, PAF(0), PAF(1), PAF(2), PAF(3)); }
#undef PKW
#undef PAF
#undef VFR
#undef PIN
#undef MX3
#undef MF32
#undef GAPA
#undef GAPC
#undef GAPB
#undef EX
#undef VRD
#undef KRD
#undef STEP
#undef ENDW
    { auto rr = __builtin_amdgcn_permlane32_swap(__float_as_uint(l_reg), __float_as_uint(l_reg), false, false); l_reg = __uint_as_float(rr[0]) + __uint_as_float(rr[1]); }
    if (hi == 0) wsf[32 + r32] = l_reg; asm volatile("s_waitcnt lgkmcnt(0)" ::: "memory");
    float rli[16];
#pragma unroll
    for (int r = 0; r < 16; ++r) rli[r] = __builtin_amdgcn_rcpf(wsf[32 + crow(r, hi)]);
    bf16_t* Yw = Y + (rowbase + q0 + wid * QBLK) * YLD + 512 + h * 64;
    { LAS bf16_t* stg = (LAS bf16_t*)(shm + LDS_OST) + wid * 2048;
#pragma unroll
      for (int r = 0; r < 16; ++r) { const int orow = crow(r, hi);
#pragma unroll
          for (int d0 = 0; d0 < 2; ++d0) stg[orow * 64 + d0 * 32 + r32] = f2bf(o[d0][r] * rli[r]); }
      asm volatile("s_waitcnt lgkmcnt(0)" ::: "memory");
#pragma unroll
      for (int i = 0; i < 4; ++i) { const int row = i * 8 + (lane >> 3), ch = lane & 7; const u32x4 v = *(const LAS u32x4*)(stg + row * 64 + ch * 8);
          bf16_t* gp = Yw + (long)row * YLD + ch * 8; const u32x4 gt = *(const u32x4*)gp; u32x4 w;
          w.x = cvtpk(bf_lo(v.x) * bf_lo(gt.x), bf_hi(v.x) * bf_hi(gt.x)); w.y = cvtpk(bf_lo(v.y) * bf_lo(gt.y), bf_hi(v.y) * bf_hi(gt.y));
          w.z = cvtpk(bf_lo(v.z) * bf_lo(gt.z), bf_hi(v.z) * bf_hi(gt.z)); w.w = cvtpk(bf_lo(v.w) * bf_lo(gt.w), bf_hi(v.w) * bf_hi(gt.w));
          if (!dry) *(u32x4*)gp = w; } }
    asm volatile("s_waitcnt lgkmcnt(0)\n\ts_barrier" ::: "memory");
#undef DMA_K
#undef DMA_V
#undef CMASK
#undef START
#undef RESC
#undef ROT
}
#undef SBAR
#undef WAIT_BAR
}

#define XB_TMO      128
#define XB_XCNT(j)  (256  + 64 * (j))
#define XB_XSUB(j)  (1280 + 64 * (j))
#define XB_XGEN(j)  (2304 + 64 * (j))
#define XB_TOP      3328
#define XB_TOPGEN   3392
#define XCD_BAR_WORDS 3456
#define XB_SPIN_CAP (1u << 18)
__device__ __forceinline__ unsigned xb_ld(unsigned* p)              { return __hip_atomic_load(p, __ATOMIC_RELAXED, __HIP_MEMORY_SCOPE_AGENT); }
__device__ __forceinline__ unsigned xb_add(unsigned* p, unsigned v) { return __hip_atomic_fetch_add(p, v, __ATOMIC_RELAXED, __HIP_MEMORY_SCOPE_AGENT); }
__device__ __forceinline__ unsigned xb_xcc_id() { return (unsigned)__builtin_amdgcn_s_getreg((3 << 11) | 20) & 0xFu; }
#define XB_SPIN(cond, bar) do { unsigned _sp = 0; while (cond) { __builtin_amdgcn_s_sleep(1); \
    if ((++_sp & 255u) == 0u) { if (xb_ld(&(bar)[XB_TMO])) break; if (_sp > XB_SPIN_CAP) { atomicAdd(&(bar)[XB_TMO], 1u); break; } } } } while (0)
struct XcdBarrier { unsigned* bar; unsigned x; volatile LAS unsigned* st; };
__device__ __forceinline__ XcdBarrier xcd_barrier_post(unsigned* bar, volatile LAS unsigned* st) {
    XcdBarrier b; b.bar = bar; b.x = xb_xcc_id(); b.st = st;
    if (threadIdx.x == 0) (void)xb_add(&bar[XB_XCNT(b.x)], 1u);
    return b;
}
__device__ __forceinline__ void xcd_barrier_complete(unsigned* bar, unsigned x, unsigned& nloc, unsigned& nx) {
    const unsigned G = gridDim.x * gridDim.y * gridDim.z;
    unsigned sum, cnt, mine, sp = 0u;
    for (;;) {
        sum = 0u; cnt = 0u; mine = 0u;
#pragma unroll
        for (unsigned j = 0; j < 16; ++j) { const unsigned c = xb_ld(&bar[XB_XCNT(j)]); sum += c; cnt += (c > 0u) ? 1u : 0u; mine = (j == x) ? c : mine; }
        if (sum == G) break;
        __builtin_amdgcn_s_sleep(1);
        if ((++sp & 255u) == 0u) { if (xb_ld(&bar[XB_TMO])) break; if (sp > XB_SPIN_CAP) { atomicAdd(&bar[XB_TMO], 1u); break; } }
    }
    nloc = mine > 0u ? mine : 1u; nx = cnt > 0u ? cnt : 1u;
}
__device__ __forceinline__ void xcd_barrier(const XcdBarrier& b) {
    asm volatile("s_waitcnt vmcnt(0)" ::: "memory");
    __syncthreads();
    if (threadIdx.x == 0) {
        unsigned* bar = b.bar;
        __builtin_amdgcn_s_waitcnt(0);
        unsigned nloc = b.st[0], nx = b.st[1];
        if (nloc == 0u) { xcd_barrier_complete(bar, b.x, nloc, nx); b.st[0] = nloc; b.st[1] = nx; }
        const unsigned old = xb_add(&bar[XB_XSUB(b.x)], 1u);
        const unsigned gen = old / nloc;
        if (old + 1u == (gen + 1u) * nloc) {
            __builtin_amdgcn_fence(__ATOMIC_RELEASE, "agent");
            asm volatile("s_waitcnt vmcnt(0)" ::: "memory");
            const unsigned og = xb_add(&bar[XB_TOP], 1u);
            const unsigned tg = og / nx;
            if (og + 1u == (tg + 1u) * nx) xb_add(&bar[XB_TOPGEN], 1u);
            else XB_SPIN(xb_ld(&bar[XB_TOPGEN]) == tg, bar);
            __builtin_amdgcn_fence(__ATOMIC_ACQUIRE, "agent");
            xb_add(&bar[XB_XGEN(b.x)], 1u);
            asm volatile("s_waitcnt vmcnt(0)" ::: "memory");
        } else {
            XB_SPIN(xb_ld(&bar[XB_XGEN(b.x)]) == gen, bar);
            __builtin_amdgcn_fence(__ATOMIC_ACQUIRE, "agent");
            asm volatile("s_waitcnt vmcnt(0)" ::: "memory");
        }
    }
    __syncthreads();
}

constexpr int NWAVES = 8;
constexpr int RING_BYTES = 131072, LDSCTL_OFF = RING_BYTES, MISC_OFF = LDSCTL_OFF + 320, LDS_BYTES = 147456;
static_assert(att::LDS_BYTES <= RING_BYTES && att2::LDS_BYTES <= RING_BYTES, "attention scratch fits the ring region");
#ifndef ATT_V
#define ATT_V 2
#endif
#ifndef PROBE_MASK
#define PROBE_MASK 0
#endif
#ifndef REP_P1
#define REP_P1 1
#endif
#ifndef REP_G
#define REP_G 1
#endif
#ifndef REP_P4
#define REP_P4 1
#endif
#ifndef REP_P5
#define REP_P5 1
#endif
#ifndef REP_ATT
#define REP_ATT 1
#endif

template <class F> __device__ __forceinline__ void transpose_item(const float* W, int ldw, bf16_t* WT, int ldwt, LAS float* scr, int k0, int n0, int lane, F scol, const float* rs = nullptr) {
    const int sc = scol(n0 + (lane & 31));
#pragma unroll 8
    for (int i = 0; i < 32; ++i) { const int kk = 2 * i + (lane >> 5); scr[kk * 33 + (lane & 31)] = sc >= 0 ? W[(size_t)(k0 + kk) * ldw + sc] * (rs ? rs[k0 + kk] : 1.f) : 0.f; }
    LDS_WAIT(); asm volatile("" ::: "memory");
    const int c = lane & 7;
#pragma unroll
    for (int j = 0; j < 4; ++j) { const int n = (lane >> 3) + 8 * j; const LAS float* s = scr + (8 * c) * 33 + n;
        u32x4 o; o.x = cvtpk(s[0 * 33], s[1 * 33]); o.y = cvtpk(s[2 * 33], s[3 * 33]); o.z = cvtpk(s[4 * 33], s[5 * 33]); o.w = cvtpk(s[6 * 33], s[7 * 33]);
        *(u32x4*)(WT + (size_t)(n0 + n) * ldwt + k0 + 8 * c) = o; }
    LDS_WAIT(); asm volatile("" ::: "memory");
}
__device__ __forceinline__ void transpose_item4(const float* W, int ldw, int sc0, bf16_t* WT, int ldwt, LAS float* scr, int k0, int n0, int lane, const float* rs = nullptr) {
    const int kr = lane >> 3, c4 = (lane & 7) * 4; f32x4 v[8];
#pragma unroll
    for (int i = 0; i < 8; ++i) { const int kk = 8 * i + kr; v[i] = sc0 >= 0 ? *(const f32x4*)(W + (size_t)(k0 + kk) * ldw + sc0 + c4) : (f32x4){0.f, 0.f, 0.f, 0.f}; if (rs) v[i] = v[i] * rs[k0 + kk]; }
#pragma unroll
    for (int i = 0; i < 8; ++i) { const int kk = 8 * i + kr;
#pragma unroll
        for (int e = 0; e < 4; ++e) scr[kk * 33 + c4 + e] = v[i][e]; }
    LDS_WAIT(); asm volatile("" ::: "memory");
    const int c = lane & 7;
#pragma unroll
    for (int j = 0; j < 4; ++j) { const int n = (lane >> 3) + 8 * j; const LAS float* s = scr + (8 * c) * 33 + n;
        u32x4 o; o.x = cvtpk(s[0 * 33], s[1 * 33]); o.y = cvtpk(s[2 * 33], s[3 * 33]); o.z = cvtpk(s[4 * 33], s[5 * 33]); o.w = cvtpk(s[6 * 33], s[7 * 33]);
        *(u32x4*)(WT + (size_t)(n0 + n) * ldwt + k0 + 8 * c) = o; }
    LDS_WAIT(); asm volatile("" ::: "memory");
}
__device__ __forceinline__ int win_scol(int n) {
    if (n < 512) return n;
    if (n < 768) return 1024 + (n - 512);
    if (n < 896) return 1280 + (n - 768);
    if (n < 928) return 1408 + (n - 896);
    if (n < 1024) return -1;
    if (n < 1536) return 1952 + (n - 1024);
    if (n < 2048) return 2464 + (n - 1536);
    if (n < 2560) return 512 + (n - 2048);
    if (n < 3072) return 1440 + (n - 2560);
    if (n < 3584) return 2976 + (n - 3072);
    return 3488 + (n - 3584);
}
__device__ __forceinline__ int wuq_scol(int n) { const int h = n / 96, d = n - h * 96; return h * 96 + (d < 64 ? d : 64 + ((d - 64) >> 1) + 16 * ((d - 64) & 1)); }

__device__ __forceinline__ void rms_row_to_bf16(const float* xrow, const float* g, bf16_t* orow, int lane) {
    const f32x4* xr = (const f32x4*)xrow + lane; f32x4 v[4]; float s = 0.f;
#pragma unroll
    for (int j = 0; j < 4; ++j) { v[j] = xr[64 * j]; s += (v[j].x * v[j].x + v[j].y * v[j].y) + (v[j].z * v[j].z + v[j].w * v[j].w); }
    const float rstd = 1.f / sqrtf(wave_sum(s) * (1.f / DM) + EPS);
    u32x2* o8 = (u32x2*)orow + lane;
#pragma unroll
    for (int j = 0; j < 4; ++j) { const f32x4 gg = ((const f32x4*)g)[lane + 64 * j]; u32x2 w; w.x = cvtpk(v[j].x * rstd * gg.x, v[j].y * rstd * gg.y); w.y = cvtpk(v[j].z * rstd * gg.z, v[j].w * rstd * gg.w); o8[64 * j] = w; }
}

struct Args { const void* in[20]; float* out; unsigned char* ws; int ph_lo, ph_hi, li, pad; };
constexpr int N_PHASES = 1 + 7 * DEPTH;

__global__ void __launch_bounds__(NWAVES * 64, 2) hybrid_fwd(Args args) {
    extern __shared__ __attribute__((aligned(16))) unsigned char lds_raw[];
    LAS unsigned char* lds = (LAS unsigned char*)lds_raw;
    volatile LAS unsigned* MISC = (volatile LAS unsigned*)(lds + MISC_OFF);
    const int G = gridDim.x, bx = blockIdx.x, vcu = (G % 8 == 0) ? (bx % 8) * (G / 8) + bx / 8 : bx;
#define LOAD_TID int tid = threadIdx.x; asm volatile("" : "+v"(tid)); const int lane = tid & 63, wave = __builtin_amdgcn_readfirstlane(tid >> 6); const int gw = vcu * NWAVES + wave, NGW = G * NWAVES; (void)lane; (void)gw; (void)NGW
    typedef __attribute__((address_space(4))) const Args* KArgs;
#define LOAD_PTRS \
    KArgs ap = (KArgs)__builtin_amdgcn_kernarg_segment_ptr(); asm volatile("" : "+s"(ap)); \
    unsigned char* ws = ap->ws; float* out = ap->out; \
    const float* x_in = (const float*)ap->in[0]; const int* positions = (const int*)ap->in[1]; \
    const float* norm_pre = (const float*)ap->in[2]; const float* norm_post = (const float*)ap->in[3]; \
    const float* w_in = (const float*)ap->in[4]; const float* b_gate = (const float*)ap->in[5]; \
    const float* pool_w = (const float*)ap->in[6]; const float* pool_scale = (const float*)ap->in[7]; \
    const float* q_norm = (const float*)ap->in[8]; const float* w_uq = (const float*)ap->in[9]; \
    const float* kv_norm = (const float*)ap->in[10]; const float* w_ukv = (const float*)ap->in[11]; \
    const float* v_norm_g = (const float*)ap->in[12]; const float* v_norm_b = (const float*)ap->in[13]; \
    const float* w_s = (const float*)ap->in[14]; const float* b_s = (const float*)ap->in[15]; \
    const float* w_oa = (const float*)ap->in[16]; const float* w_ob = (const float*)ap->in[17]; const float* w_oc = (const float*)ap->in[18]; \
    const float* w_out = (const float*)ap->in[19]; \
    float* CS = (float*)(ws + WS_CS); \
    bf16_t* Hb = (bf16_t*)(ws + WS_H); bf16_t* PROJ = (bf16_t*)(ws + WS_PROJ); bf16_t* GATES = (bf16_t*)(ws + WS_PROJ); float* Z = (float*)(ws + WS_PROJ); \
    bf16_t* Qb = (bf16_t*)(ws + WS_Q); bf16_t* Kb = (bf16_t*)(ws + WS_K); bf16_t* Vb = (bf16_t*)(ws + WS_V); bf16_t* Yb = (bf16_t*)(ws + WS_Y); \
    float* SSQ = (float*)(ws + WS_SSQ); bf16_t* KRb = (bf16_t*)(ws + WS_KR); (void)SSQ; (void)KRb; \
    unsigned char* wl = ws + WS_W + (size_t)l * W_LAYER; const bf16_t* Win_t = (const bf16_t*)(wl + W_IN); const float* x_prev = l == 0 ? x_in : out; \
    (void)positions; (void)norm_pre; (void)norm_post; (void)w_in; (void)b_gate; (void)pool_w; (void)pool_scale; (void)q_norm; (void)w_uq; (void)kv_norm; (void)w_ukv; (void)v_norm_g; (void)v_norm_b; \
    (void)w_s; (void)b_s; (void)w_oa; (void)w_ob; (void)w_oc; (void)w_out; (void)CS; (void)Hb; (void)PROJ; (void)GATES; (void)Z; (void)Qb; (void)Kb; (void)Vb; (void)Yb; (void)Win_t; (void)x_prev; (void)x_in; (void)out
    unsigned* ctl = (unsigned*)(args.ws + WS_CTL);
    for (int u = threadIdx.x; u < (LDS_BYTES - LDSCTL_OFF) / 4; u += NWAVES * 64) ((LAS unsigned*)(lds + LDSCTL_OFF))[u] = 0u;
    __syncthreads();
    XcdBarrier bar; bar.bar = ctl + CW_BAR; bar.x = 0; bar.st = nullptr;
#if MK_SINGLE
    bar = xcd_barrier_post(ctl + CW_BAR, MISC + 8);
#define GRID_BAR() xcd_barrier(bar)
#else
    (void)MISC; (void)bar;
#define GRID_BAR() do { } while (0)
#endif
    const int lo = args.ph_lo, hi = args.ph_hi;
    if (PROBE_MASK != 0 && blockIdx.x == 0 && threadIdx.x == 0) { const unsigned long long now_ = __builtin_amdgcn_s_memrealtime(); MISC[16] = (unsigned)now_; MISC[17] = (unsigned)(now_ >> 32); MISC[18] = 0; MISC[19] = 0; }
#ifdef ONLYP
#define IN(k) ((((k) - 1) % 7) + 1 == ONLYP && (k) > 0 && lo <= (k) && (k) < hi || (ONLYP == 0 && (k) == 0 && lo == 0))
#else
#define IN(k) (lo <= (k) && (k) < hi)
#endif
#define SEAM(k) do { if (IN(k) && IN((k) + 1)) GRID_BAR(); \
    if (PROBE_MASK != 0 && blockIdx.x == 0 && threadIdx.x == 0) { const unsigned long long now_ = __builtin_amdgcn_s_memrealtime(); const int ty_ = (k) == 0 ? 0 : (((k) - 1) % 7) + 1; \
        unsigned long long prev_ = ((unsigned long long)MISC[17] << 32) | MISC[16], acc_ = ((unsigned long long)MISC[19] << 32) | MISC[18]; \
        if ((PROBE_MASK >> ty_) & 1) acc_ += now_ - prev_; MISC[16] = (unsigned)now_; MISC[17] = (unsigned)(now_ >> 32); MISC[18] = (unsigned)acc_; MISC[19] = (unsigned)(acc_ >> 32); } } while (0)

    if (IN(0)) {
        const int l = 0; LOAD_PTRS; LOAD_TID;
        LAS float* scr = (LAS float*)(lds + wave * 16384);
        constexpr int I_IN = 16 * (NIN / 32), I_UQ = 4 * 24, I_UKV = 2 * 32, I_POOL = 4 * 2 * 4, I_O = 8 * 32, I_OUT = 16 * 32;
        constexpr int I_LAYER = I_IN + I_UQ + I_UKV + I_POOL + 3 * I_O + I_OUT;
        for (int it = gw; it < DEPTH * I_LAYER; it += NGW) {
            const int l = it / I_LAYER; int r = it - l * I_LAYER;
            unsigned char* wl = ws + WS_W + (size_t)l * W_LAYER;
            if (r < I_IN) { const int nb = r % (NIN / 32), kb = r / (NIN / 32);
                transpose_item4(w_in + (size_t)l * DM * 6560, 6560, win_scol(32 * nb), (bf16_t*)(wl + W_IN), 1024, scr, 64 * kb, 32 * nb, lane); continue; } r -= I_IN;
            if (r < I_UQ) { const int nb = r % 24, kb = r / 24;
                transpose_item(w_uq + (size_t)l * 256 * 768, 768, (bf16_t*)(wl + W_UQ), 256, scr, 64 * kb, 32 * nb, lane, [](int n) { return wuq_scol(n); }, q_norm + l * 256); continue; } r -= I_UQ;
            if (r < I_UKV) { const int nb = r % 32, kb = r / 32;
                transpose_item4(w_ukv + (size_t)l * 128 * 1024, 1024, 32 * nb, (bf16_t*)(wl + W_UKV), 256, scr, 64 * kb, 32 * nb, lane, kv_norm + l * 128); continue; } r -= I_UKV;
            if (r < I_POOL) { const int g = r >> 3, kb = (r >> 2) & 1, nb = r & 3;
                bf16_t* dst = (bf16_t*)(wl + W_POOL) + (size_t)(g >> 1) * 65536 + (size_t)(128 * (g & 1)) * 256 + 128 * (g & 1);
                transpose_item4(pool_w + (size_t)l * 65536 + (size_t)g * 16384, 128, 32 * nb, dst, 256, scr, 64 * kb, 32 * nb, lane); continue; } r -= I_POOL;
            if (r < 3 * I_O) { const int wsel = r / I_O, rr = r % I_O, nb = rr % 32, kb = rr / 32; const float* src = wsel == 0 ? w_oa : wsel == 1 ? w_ob : w_oc;
                transpose_item4(src + (size_t)l * 512 * 1024, 1024, 32 * nb, (bf16_t*)(wl + W_OA) + (size_t)wsel * 1024 * 512, 512, scr, 64 * kb, 32 * nb, lane); continue; } r -= 3 * I_O;
            { const int nb = r % 32, kb = r / 32;
                transpose_item4(w_out + (size_t)l * 1024 * 1024, 1024, 32 * nb, (bf16_t*)(wl + W_OUT), 1024, scr, 64 * kb, 32 * nb, lane); }
        }
        const int gt = vcu * 512 + tid, NGT = G * 512;
        for (int i = gt; i < DEPTH * 2 * 2 * 16384; i += NGT) { const int l = i / 65536, r = i % 65536, pr = r / 32768, ob = (r / 16384) & 1, e = r % 16384, rr = e / 128, cc = e % 128;
            bf16_t* dst = (bf16_t*)(ws + WS_W + (size_t)l * W_LAYER + W_POOL) + (size_t)pr * 65536; dst[(size_t)(128 * ob + rr) * 256 + 128 * (1 - ob) + cc] = 0; }
        for (int i = gt; i < DEPTH * 8 * 16384; i += NGT) { const int l = i / 131072, r = i % 131072, e = r % 16384, t = e / 128, s = e % 128;
            ((bf16_t*)(ws + WS_W + (size_t)l * W_LAYER + W_S))[r] = f2bf(s <= t ? w_s[i] : 0.f); }
        for (int i = gt; i < M * 16; i += NGT) { const int row = i >> 4, j = i & 15; const float inv = powf(10000.f, -(float)(2 * j) / 32.f); const float ang = (float)positions[row] * inv;
            float sn, cn; sincosf(ang, &sn, &cn); CS[(size_t)row * 32 + 2 * j] = cn; CS[(size_t)row * 32 + 2 * j + 1] = sn; }
        for (int m = gw; m < M; m += NGW) rms_row_to_bf16(x_in + (size_t)m * DM, norm_pre, Hb + (size_t)m * DM, lane);
    }
    SEAM(0);

#pragma unroll 1
    for (int l = 0; l < DEPTH; ++l) {
        const int pb = 1 + 7 * l;

        if (IN(pb + 0)) {
            LOAD_PTRS; LOAD_TID;
            pg8::Prob P{}; P.A = Hb; P.Bt = Win_t; P.lda = DM; P.ldb = DM; P.K = DM; P.T.init(M, NPROJ, G, bx); P.nbr = 1;
            pg8::EpiProj E{PROJ, Yb, SSQ, KRb, CS};
            for (int rep = 0; rep < REP_P1; ++rep) pg8::gemm_phase<pg8::EpiProj, true, true>(lds, P, E);
        }
        SEAM(pb + 0);

        if (IN(pb + 1)) {
            LOAD_PTRS; LOAD_TID;
            { pg8::ProbMix P{}; P.A = PROJ; P.wl = wl; P.lda = PLD; P.ldb = 256; P.G = G; P.c = bx;
              pg8::EpiMix E{Kb, Vb, Qb, PROJ, CS, SSQ};
              pg8::gemm_phase<pg8::EpiMix, true, true>(lds, P, E); }
            __syncthreads();
            {
                const bf16_t* Wsb = (const bf16_t*)(wl + W_S);
                LAS f32x2* stat = (LAS f32x2*)(lds + RING_BYTES + 1024);
#ifndef NO_GMLP
                for (int ch = (bx + G / 2) % G; ch < M / 128; ch += G) {
#else
                for (int ch = M; ch < M / 128; ch += G) {
#endif
                    const int g = wave; LAS unsigned char* img = lds + wave * 16384;
                    const int r32 = lane & 31, hi = lane >> 5;
                    const bf16_t* vsrc = PROJ + (size_t)(ch * 128) * PLD + 1536 + 64 * g;
                    u32x4 vt[16];
#pragma unroll
                    for (int hh = 0; hh < 2; ++hh)
#pragma unroll
                        for (int i = 0; i < 8; ++i) vt[hh * 8 + i] = *(const u32x4*)(vsrc + (size_t)(16 * i + (lane >> 2)) * PLD + 32 * hh + (lane & 3) * 8);
                    f32x4 gv[2][2], bv[2][2];
#pragma unroll
                    for (int hh = 0; hh < 2; ++hh)
#pragma unroll
                        for (int q = 0; q < 2; ++q) { const int c = 64 * g + 32 * hh + 8 * (lane & 3) + 4 * q; gv[hh][q] = *(const f32x4*)(v_norm_g + l * 512 + c); bv[hh][q] = *(const f32x4*)(v_norm_b + l * 512 + c); }
#pragma unroll
                    for (int i = 0; i < 8; ++i) { float s1 = 0.f, s2 = 0.f;
#pragma unroll
                        for (int hh = 0; hh < 2; ++hh) { const u32x4 w = vt[hh * 8 + i]; const float f[8] = {bf_lo(w.x), bf_hi(w.x), bf_lo(w.y), bf_hi(w.y), bf_lo(w.z), bf_hi(w.z), bf_lo(w.w), bf_hi(w.w)};
#pragma unroll
                            for (int e = 0; e < 8; ++e) { s1 += f[e]; s2 += f[e] * f[e]; } }
                        s1 += __shfl_xor(s1, 1); s2 += __shfl_xor(s2, 1); s1 += __shfl_xor(s1, 2); s2 += __shfl_xor(s2, 2);
                        if ((lane & 3) == 0) stat[(16 * i + (lane >> 2)) * 8 + g] = (f32x2){s1, s2}; }
                    LDS_WAIT(); __syncthreads();
#pragma unroll
                    for (int i = 0; i < 16; ++i) asm volatile("" : "+v"(vt[i]));
#pragma unroll
                    for (int i = 0; i < 8; ++i) { const int row = 16 * i + (lane >> 2); float S1 = 0.f, S2 = 0.f;
#pragma unroll
                        for (int q = 0; q < 4; ++q) { const f32x4 st = *(const LAS f32x4*)(stat + row * 8 + 2 * q); S1 += st[0] + st[2]; S2 += st[1] + st[3]; }
                        const float mean = S1 * (1.f / 512.f), rstd = 1.f / sqrtf(fmaxf(S2 * (1.f / 512.f) - mean * mean, 0.f) + EPS);
#pragma unroll
                        for (int hh = 0; hh < 2; ++hh) { const u32x4 w = vt[hh * 8 + i]; const f32x4 g0 = gv[hh][0], g1 = gv[hh][1], b0 = bv[hh][0], b1 = bv[hh][1]; u32x4 o;
                            o.x = cvtpk((bf_lo(w.x) - mean) * rstd * g0[0] + b0[0], (bf_hi(w.x) - mean) * rstd * g0[1] + b0[1]); o.y = cvtpk((bf_lo(w.y) - mean) * rstd * g0[2] + b0[2], (bf_hi(w.y) - mean) * rstd * g0[3] + b0[3]);
                            o.z = cvtpk((bf_lo(w.z) - mean) * rstd * g1[0] + b1[0], (bf_hi(w.z) - mean) * rstd * g1[1] + b1[1]); o.w = cvtpk((bf_lo(w.w) - mean) * rstd * g1[2] + b1[2], (bf_hi(w.w) - mean) * rstd * g1[3] + b1[3]);
                            *(LAS u32x4*)(img + hh * 8192 + row * 64 + (lane & 3) * 16) = o; } }
                    LDS_WAIT(); asm volatile("" ::: "memory");
                    const bf16_t* wg = Wsb + (size_t)g * 16384 + (size_t)r32 * 128 + 8 * hi;
                    bf16x8 af[20];
#pragma unroll
                    for (int ti = 0; ti < 4; ++ti)
#pragma unroll
                        for (int ks = 0; ks <= 2 * ti + 1; ++ks) af[ti * (ti + 1) + ks] = *(const bf16x8*)(wg + (size_t)(32 * ti) * 128 + 16 * ks);
                    const att::lds_cptr vp = (att::lds_cptr)img + (8 * hi + ((lane & 15) >> 2)) * 64 + ((lane >> 4) & 1) * 32 + (lane & 3) * 8;
#pragma unroll
                    for (int hh = 0; hh < 2; ++hh) {
                        bf16x8 bfr[8];
#pragma unroll
                        for (int ks = 0; ks < 8; ++ks) { const s16x4 l0 = att::vtr(vp + hh * 8192 + ks * 1024), h0 = att::vtr(vp + hh * 8192 + ks * 1024 + 256);
                            bfr[ks] = (bf16x8){l0[0], l0[1], l0[2], l0[3], h0[0], h0[1], h0[2], h0[3]}; }
                        LDS_WAIT(); asm volatile("" ::: "memory");
                        LAS bf16_t* stg = (LAS bf16_t*)(img + hh * 8192);
#pragma unroll
                        for (int ti = 0; ti < 4; ++ti) {
                            f32x16 a0 = f32x16{};
#pragma unroll
                            for (int ks = 0; ks <= 2 * ti + 1; ++ks) a0 = __builtin_amdgcn_mfma_f32_32x32x16_bf16(af[ti * (ti + 1) + ks], bfr[ks], a0, 0, 0, 0);
#pragma unroll
                            for (int r = 0; r < 16; ++r) { const int t = 32 * ti + att::crow(r, hi); stg[t * 32 + r32] = f2bf(a0[r]); }
                        }
                        asm volatile("" ::: "memory");
                    }
                    LDS_WAIT(); asm volatile("" ::: "memory");
                    const float* bs = b_s + (size_t)l * 1024 + g * 128;
#pragma unroll 4
                    for (int it = 0; it < 16; ++it) { const int t = it * 8 + (lane >> 3), c8 = (lane & 7) * 8; const size_t row = (size_t)(ch * 128 + t);
                        const u32x4 sv = *(const LAS u32x4*)(img + (c8 >> 5) * 8192 + t * 64 + (c8 & 31) * 2); const float bb = bs[t];
                        const u32x4 uu = *(const u32x4*)(PROJ + row * PLD + 1024 + 64 * g + c8); bf16_t* yp = Yb + row * YLD + 1024 + 64 * g + c8; const u32x4 gt = *(const u32x4*)yp;
                        u32x4 w;
                        w.x = cvtpk(bf_lo(uu.x) * (bf_lo(sv.x) + bb) * bf_lo(gt.x), bf_hi(uu.x) * (bf_hi(sv.x) + bb) * bf_hi(gt.x));
                        w.y = cvtpk(bf_lo(uu.y) * (bf_lo(sv.y) + bb) * bf_lo(gt.y), bf_hi(uu.y) * (bf_hi(sv.y) + bb) * bf_hi(gt.y));
                        w.z = cvtpk(bf_lo(uu.z) * (bf_lo(sv.z) + bb) * bf_lo(gt.z), bf_hi(uu.z) * (bf_hi(sv.z) + bb) * bf_hi(gt.z));
                        w.w = cvtpk(bf_lo(uu.w) * (bf_lo(sv.w) + bb) * bf_lo(gt.w), bf_hi(uu.w) * (bf_hi(sv.w) + bb) * bf_hi(gt.w));
                        *(u32x4*)yp = w; }
                    LDS_WAIT(); __syncthreads();
                }
            }
        }
        SEAM(pb + 1);

        if (IN(pb + 2)) {
            LOAD_PTRS; LOAD_TID;
            const float* psc = pool_scale + l * 512;
            for (int strip = gw; strip < M / 8; strip += NGW) {
                const int m0 = strip * 8, tau0 = m0 & (SEQ - 1), c0 = 8 * lane, grp = lane >> 4, w = 2 << grp;
                u32x4 v[23];
#pragma unroll
                for (int i = 0; i < 23; ++i) { v[i] = (u32x4){0u, 0u, 0u, 0u}; if (i >= 16 - w && tau0 - 15 + i >= 0) v[i] = *(const u32x4*)(PROJ + (size_t)(m0 - 15 + i) * PLD + c0); }
                u32x4 gt[8];
#pragma unroll
                for (int o = 0; o < 8; ++o) gt[o] = *(const u32x4*)(Yb + (size_t)(m0 + o) * YLD + c0);
                const f32x4 s0 = *(const f32x4*)(psc + c0), s1 = *(const f32x4*)(psc + c0 + 4);
                float sum[8];
#pragma unroll
                for (int e = 0; e < 8; ++e) sum[e] = 0.f;
#pragma unroll
                for (int j = 1; j < 16; ++j) { const u32x4 x = v[15 - j];
                    sum[0] += bf_lo(x.x); sum[1] += bf_hi(x.x); sum[2] += bf_lo(x.y); sum[3] += bf_hi(x.y); sum[4] += bf_lo(x.z); sum[5] += bf_hi(x.z); sum[6] += bf_lo(x.w); sum[7] += bf_hi(x.w); }
#pragma unroll
                for (int o = 0; o < 8; ++o) { const u32x4 x = v[15 + o];
                    const float pc[8] = {bf_lo(x.x), bf_hi(x.x), bf_lo(x.y), bf_hi(x.y), bf_lo(x.z), bf_hi(x.z), bf_lo(x.w), bf_hi(x.w)};
#pragma unroll
                    for (int e = 0; e < 8; ++e) sum[e] += pc[e];
                    const int tau = tau0 + o; const float inv = 1.f / (float)(tau + 1 < w ? tau + 1 : w);
                    const u32x4 g4 = gt[o]; u32x4 r;
                    r.x = cvtpk((sum[0] * inv - pc[0]) * s0[0] * bf_lo(g4.x), (sum[1] * inv - pc[1]) * s0[1] * bf_hi(g4.x));
                    r.y = cvtpk((sum[2] * inv - pc[2]) * s0[2] * bf_lo(g4.y), (sum[3] * inv - pc[3]) * s0[3] * bf_hi(g4.y));
                    r.z = cvtpk((sum[4] * inv - pc[4]) * s1[0] * bf_lo(g4.z), (sum[5] * inv - pc[5]) * s1[1] * bf_hi(g4.z));
                    r.w = cvtpk((sum[6] * inv - pc[6]) * s1[2] * bf_lo(g4.w), (sum[7] * inv - pc[7]) * s1[3] * bf_hi(g4.w));
                    *(u32x4*)(Yb + (size_t)(m0 + o) * YLD + c0) = r;
                    const u32x4 xa = v[15 + o - 1], xb = v[15 + o - 3], xc = v[15 + o - 7], xd = v[15 + o - 15];
                    const u32x4 xo = grp == 0 ? xa : grp == 1 ? xb : grp == 2 ? xc : xd;
                    sum[0] -= bf_lo(xo.x); sum[1] -= bf_hi(xo.x); sum[2] -= bf_lo(xo.y); sum[3] -= bf_hi(xo.y); sum[4] -= bf_lo(xo.z); sum[5] -= bf_hi(xo.z); sum[6] -= bf_lo(xo.w); sum[7] -= bf_hi(xo.w); }
            }
            __syncthreads();
            const unsigned lds0 = (unsigned)(uintptr_t)lds_raw;
            for (int rep = 0; rep < REP_ATT; ++rep)
            for (int k = vcu; k < 512; k += G) { const int p = k & 255, bh = p >> 4, s = p & 15; const int qb = k < 256 ? s : 31 - s;
#if ATT_V == 2
                att2::attn_unit<8>(bh >> 3, bh & 7, qb, Qb, Kb, KRb, Vb, Yb, (LAS char*)lds, lds0, rep + 1 < REP_ATT);
#else
                att::attn_unit(bh >> 3, bh & 7, qb, Qb, Kb, KRb, Vb, Yb, (LAS char*)lds, lds0);
#endif
            }
            __syncthreads();
        }
        SEAM(pb + 2);

        if (IN(pb + 3)) {
            LOAD_PTRS; LOAD_TID;
            pg8::Prob P{}; P.A = Hb; P.Bt = Win_t + (size_t)NPROJ * DM; P.lda = DM; P.ldb = DM; P.K = DM; P.T.init(M, NGATE, G, bx); P.nbr = 1;
            pg8::EpiGate E{GATES, b_gate + l * NGATE};
            for (int rep = 0; rep < REP_G; ++rep) pg8::gemm_phase<pg8::EpiGate, true, true>(lds, P, E);
        }
        SEAM(pb + 3);

        if (IN(pb + 4)) {
            LOAD_PTRS; LOAD_TID;
            pg8::Prob P{}; P.A = Yb; P.Bt = (const bf16_t*)(wl + W_OA); P.lda = YLD; P.ldb = 512; P.K = 512; P.T.init(M, DM, G, bx); P.nbr = 3; P.a_col_per_br = 512; P.b_per_br = (size_t)1024 * 512;
            pg8::EpiMerge E{GATES, Hb};
            for (int rep = 0; rep < REP_P4; ++rep) pg8::gemm_phase<pg8::EpiMerge, false, true>(lds, P, E);
        }
        SEAM(pb + 4);

        if (IN(pb + 5)) {
            LOAD_PTRS; LOAD_TID;
            pg8::Prob P{}; P.A = Hb; P.Bt = (const bf16_t*)(wl + W_OUT); P.lda = DM; P.ldb = DM; P.K = DM; P.T.init(M, DM, G, bx); P.nbr = 1;
            pg8::EpiZ E{Z};
            for (int rep = 0; rep < REP_P5; ++rep) pg8::gemm_phase<pg8::EpiZ, false, true>(lds, P, E);
        }
        SEAM(pb + 5);

        if (IN(pb + 6)) {
            LOAD_PTRS; LOAD_TID;
            const float* gp = norm_post + l * DM; const float* gn = norm_pre + (l + 1 < DEPTH ? l + 1 : l) * DM;
            for (int m = gw; m < M; m += NGW) {
                const f32x4* zr = (const f32x4*)(Z + (size_t)m * DM) + lane; const f32x4* xr = (const f32x4*)(x_prev + (size_t)m * DM) + lane; f32x4* orow = (f32x4*)(out + (size_t)m * DM) + lane;
                f32x4 v[4]; float s = 0.f;
#pragma unroll
                for (int j = 0; j < 4; ++j) { v[j] = zr[64 * j]; s += (v[j].x * v[j].x + v[j].y * v[j].y) + (v[j].z * v[j].z + v[j].w * v[j].w); }
                const float rstd = 1.f / sqrtf(wave_sum(s) * (1.f / DM) + EPS); float s2 = 0.f;
#pragma unroll
                for (int j = 0; j < 4; ++j) { const f32x4 g = ((const f32x4*)gp)[lane + 64 * j]; v[j] = xr[64 * j] + v[j] * rstd * g; orow[64 * j] = v[j];
                    s2 += (v[j].x * v[j].x + v[j].y * v[j].y) + (v[j].z * v[j].z + v[j].w * v[j].w); }
                if (l + 1 < DEPTH) { const float r2 = 1.f / sqrtf(wave_sum(s2) * (1.f / DM) + EPS); u32x2* o8 = (u32x2*)(Hb + (size_t)m * DM) + lane;
#pragma unroll
                    for (int j = 0; j < 4; ++j) { const f32x4 g = ((const f32x4*)gn)[lane + 64 * j]; u32x2 w; w.x = cvtpk(v[j].x * r2 * g.x, v[j].y * r2 * g.y); w.y = cvtpk(v[j].z * r2 * g.z, v[j].w * r2 * g.w); o8[64 * j] = w; } }
            }
        }
        SEAM(pb + 6);
    }
    if (PROBE_MASK != 0 && blockIdx.x == 0 && threadIdx.x == 0) { const unsigned long long acc_ = ((unsigned long long)MISC[19] << 32) | MISC[18], t0_ = __builtin_amdgcn_s_memrealtime();
        while (__builtin_amdgcn_s_memrealtime() - t0_ < acc_) __builtin_amdgcn_s_sleep(8); }
#undef IN
#undef SEAM
}

extern "C" void kernel_launch(void* const* d_in, const int* in_sizes, int n_in, void* d_out, int out_size, void* d_ws, size_t ws_size, hipStream_t stream) {
    static int grid = 0;
    if (grid == 0) {
        if (n_in != 20 || out_size != M * DM || ws_size < WS_END) { fprintf(stderr, "kernel_launch: unexpected shapes (n_in %d out %d ws %zu)\n", n_in, out_size, ws_size); grid = -1; return; }
        int dev = 0, cus = 0, per_cu = 0;
        if (hipGetDevice(&dev) != hipSuccess || hipDeviceGetAttribute(&cus, hipDeviceAttributeMultiprocessorCount, dev) != hipSuccess) { grid = -1; return; }
        if (hipFuncSetAttribute((const void*)hybrid_fwd, hipFuncAttributeMaxDynamicSharedMemorySize, LDS_BYTES) != hipSuccess) { fprintf(stderr, "kernel_launch: hipFuncSetAttribute failed\n"); grid = -1; return; }
        if (hipOccupancyMaxActiveBlocksPerMultiprocessor(&per_cu, (const void*)hybrid_fwd, NWAVES * 64, LDS_BYTES) != hipSuccess || per_cu < 1) { fprintf(stderr, "kernel_launch: occupancy query says %d\n", per_cu); per_cu = 1; }
        (void)hipGetLastError();
        grid = cus;
    }
    if (grid < 0) return;
    (void)hipMemsetAsync((char*)d_ws + WS_CTL, 0, CTL_ZERO_BYTES, stream);
    Args a{};
    for (int i = 0; i < 20; ++i) a.in[i] = d_in[i];
    a.out = (float*)d_out; a.ws = (unsigned char*)d_ws;
#if MK_SINGLE
    a.ph_lo = 0; a.ph_hi = N_PHASES; a.li = 0;
    hipLaunchKernelGGL(hybrid_fwd, dim3(grid), dim3(NWAVES * 64), LDS_BYTES, stream, a);
#else
    for (int p = 0; p < N_PHASES; ++p) { a.ph_lo = p; a.ph_hi = p + 1; a.li = p; hipLaunchKernelGGL(hybrid_fwd, dim3(grid), dim3(NWAVES * 64), LDS_BYTES, stream, a); }
#endif
}
```
